# Optimizing an MI355X kernel written in HIP

```python
import jax, jax.numpy as jnp
from jax import lax
import numpy as np

D_MODEL = 1024
BATCH = 8
SEQ = 2048
DEPTH = 1

CHUNK = 64
PLE_DIM = 256
EPS = 1e-6
GMLP_GROUPS = 8
GMLP_GROUP_DIM = 128
GMLP_WIDTH = GMLP_GROUPS * GMLP_GROUP_DIM
GMLP_BLOCK = 128
FOX_HEADS = 16
FOX_HEAD_DIM = 64
FOX_WIDTH = FOX_HEADS * FOX_HEAD_DIM
Q_BLOCK = 128
D_FF = 2816
CONV_WIDTH = 3
N_BRANCH = 2
IN_COLS = 2 * GMLP_WIDTH + 3 * FOX_WIDTH + FOX_HEADS + N_BRANCH * D_MODEL

kernel_name = "hybrid_gmlp_fox_convffn_block"


def rmsnorm(x, g):
    x32 = x.astype(jnp.float32)
    y = x32 * lax.rsqrt(jnp.mean(x32 * x32, axis=-1, keepdims=True) + EPS)
    return (y * g.astype(jnp.float32)).astype(x.dtype)


def layernorm(x, g, b):
    x32 = x.astype(jnp.float32)
    mu = jnp.mean(x32, axis=-1, keepdims=True)
    xc = x32 - mu
    y = xc * lax.rsqrt(jnp.mean(xc * xc, axis=-1, keepdims=True) + EPS)
    return (y * g.astype(jnp.float32) + b.astype(jnp.float32)).astype(x.dtype)


def gmlp_spatial_gating(z_u, z_v, ln_g, ln_b, w_s, b_s):
    B, S, _ = z_u.shape
    v = layernorm(z_v, ln_g, ln_b)
    v = v.reshape(B, S // GMLP_BLOCK, GMLP_BLOCK, GMLP_GROUPS, GMLP_GROUP_DIM)
    pos = jnp.arange(GMLP_BLOCK)
    mask = (pos[None, :] // CHUNK) <= (pos[:, None] // CHUNK)
    w = jnp.where(mask[None], w_s, jnp.zeros_like(w_s))
    mixed = jnp.einsum('gts,bnsgc->bntgc', w, v) + b_s.T[None, None, :, :, None]
    return z_u * mixed.reshape(B, S, GMLP_WIDTH)


def forgetting_attention(q, k, v, f_logit, b_f):
    B, S, _ = q.shape
    def heads(t):
        return t.reshape(B, S, FOX_HEADS, FOX_HEAD_DIM).transpose(0, 2, 1, 3)
    q, k, v = heads(q), heads(k), heads(v)
    log_f = jax.nn.log_sigmoid(f_logit.astype(jnp.float32) + b_f.astype(jnp.float32))
    cum = jnp.cumsum(log_f, axis=1).transpose(0, 2, 1)
    scale = FOX_HEAD_DIM ** -0.5
    outs = []
    for i in range(S // Q_BLOCK):
        lo, hi = i * Q_BLOCK, (i + 1) * Q_BLOCK
        s = jnp.einsum('bhqd,bhkd->bhqk', q[:, :, lo:hi], k[:, :, :hi]).astype(jnp.float32) * scale
        s = s + cum[:, :, lo:hi, None] - cum[:, :, None, :hi]
        qpos = jnp.arange(lo, hi)
        kpos = jnp.arange(hi)
        s = jnp.where(kpos[None, :] <= qpos[:, None], s, -1e30)
        prob = jax.nn.softmax(s, axis=-1).astype(v.dtype)
        outs.append(jnp.einsum('bhqk,bhkd->bhqd', prob, v[:, :, :hi]))
    o = jnp.concatenate(outs, axis=2)
    return o.transpose(0, 2, 1, 3).reshape(B, S, FOX_WIDTH)


def causal_depthwise_conv(u, w, b):
    S = u.shape[1]
    up = jnp.pad(u, ((0, 0), (CONV_WIDTH - 1, 0), (0, 0)))
    out = b + w[0] * up[:, 0:S]
    for j in range(1, CONV_WIDTH):
        out = out + w[j] * up[:, j:j + S]
    return out


def setup_inputs(seed: int = 0) -> dict:
    key = jax.random.key(seed)
    ks = jax.random.split(key, 24)
    f32 = jnp.float32
    def nrm(k, shape, scale):
        return jax.random.normal(k, shape, f32) * scale
    L = DEPTH
    return {
        "x": nrm(ks[0], (BATCH, SEQ, D_MODEL), 1.0),
        "p": nrm(ks[1], (DEPTH, BATCH, SEQ, PLE_DIM), 1.0),
        "norm_mix_g": 1.0 + nrm(ks[2], (L, D_MODEL), 0.02),
        "w_in": nrm(ks[3], (L, D_MODEL, IN_COLS), D_MODEL ** -0.5),
        "b_f": 2.0 + nrm(ks[4], (L, FOX_HEADS), 0.5),
        "gmlp_ln_g": 1.0 + nrm(ks[5], (L, GMLP_WIDTH), 0.02),
        "gmlp_ln_b": nrm(ks[6], (L, GMLP_WIDTH), 0.02),
        "gmlp_w_s": nrm(ks[7], (L, GMLP_GROUPS, GMLP_BLOCK, GMLP_BLOCK), GMLP_BLOCK ** -0.5),
        "gmlp_b_s": 1.0 + nrm(ks[8], (L, GMLP_GROUPS, GMLP_BLOCK), 0.1),
        "w_branch_a": nrm(ks[9], (L, GMLP_WIDTH, D_MODEL), GMLP_WIDTH ** -0.5),
        "w_branch_b": nrm(ks[10], (L, FOX_WIDTH, D_MODEL), FOX_WIDTH ** -0.5),
        "w_out": nrm(ks[11], (L, D_MODEL, D_MODEL), D_MODEL ** -0.5),
        "norm_ffn_g": 1.0 + nrm(ks[12], (L, D_MODEL), 0.02),
        "w_up": nrm(ks[13], (L, D_MODEL, 2 * D_FF), D_MODEL ** -0.5),
        "conv_w": nrm(ks[14], (L, CONV_WIDTH, 2 * D_FF), CONV_WIDTH ** -0.5),
        "conv_b": nrm(ks[15], (L, 2 * D_FF), 0.02),
        "w_down": nrm(ks[16], (L, D_FF, D_MODEL), D_FF ** -0.5),
        "norm_ple_g": 1.0 + nrm(ks[17], (L, D_MODEL), 0.02),
        "w_ple": nrm(ks[18], (L, PLE_DIM, D_MODEL), PLE_DIM ** -0.5),
        "w_ple_gate": nrm(ks[19], (L, D_MODEL, D_MODEL), D_MODEL ** -0.5),
        "norm_final_g": 1.0 + nrm(ks[20], (D_MODEL,), 0.02),
    }


def reference(x, p, norm_mix_g, w_in, b_f, gmlp_ln_g, gmlp_ln_b, gmlp_w_s, gmlp_b_s,
              w_branch_a, w_branch_b, w_out, norm_ffn_g, w_up, conv_w, conv_b, w_down,
              norm_ple_g, w_ple, w_ple_gate, norm_final_g):
    o1 = 2 * GMLP_WIDTH
    o2 = o1 + 3 * FOX_WIDTH
    o3 = o2 + FOX_HEADS
    for i in range(DEPTH):
        h = rmsnorm(x, norm_mix_g[i])
        z = jnp.einsum('bsd,dc->bsc', h, w_in[i])
        uv = jax.nn.gelu(z[..., :o1])
        z_u, z_v = uv[..., :GMLP_WIDTH], uv[..., GMLP_WIDTH:]
        q = z[..., o1:o1 + FOX_WIDTH]
        k = z[..., o1 + FOX_WIDTH:o1 + 2 * FOX_WIDTH]
        v = z[..., o1 + 2 * FOX_WIDTH:o2]
        f_logit = z[..., o2:o3]
        gates = jax.nn.sigmoid(z[..., o3:])
        gate_a, gate_b = gates[..., :D_MODEL], gates[..., D_MODEL:]

        a = gmlp_spatial_gating(z_u, z_v, gmlp_ln_g[i], gmlp_ln_b[i], gmlp_w_s[i], gmlp_b_s[i])
        b = forgetting_attention(q, k, v, f_logit, b_f[i])
        y_a = jnp.einsum('bsc,cd->bsd', a, w_branch_a[i])
        y_b = jnp.einsum('bsc,cd->bsd', b, w_branch_b[i])
        merged = gate_a * y_a + gate_b * y_b
        x = x + jnp.einsum('bsd,de->bse', merged, w_out[i])

        h2 = rmsnorm(x, norm_ffn_g[i])
        up = jnp.einsum('bsd,df->bsf', h2, w_up[i])
        up = causal_depthwise_conv(up, conv_w[i], conv_b[i])
        act = jax.nn.gelu(up[..., :D_FF]) * up[..., D_FF:]
        x = x + jnp.einsum('bsf,fd->bsd', act, w_down[i])

        h3 = rmsnorm(x, norm_ple_g[i])
        ple = jnp.einsum('bse,ed->bsd', p[i], w_ple[i])
        x = x + ple * jax.nn.sigmoid(jnp.einsum('bsd,de->bse', h3, w_ple_gate[i]))
    return rmsnorm(x, norm_final_g)
```

```cpp
#include <hip/hip_runtime.h>
#include <hip/hip_cooperative_groups.h>
#include <hip/hip_bf16.h>
#include <cstdio>
#include <cstdint>
#include <cmath>
namespace pg8 {
#define PG8_LAS __attribute__((address_space(3)))
typedef unsigned short bf16_t;
typedef short bf16x8 __attribute__((ext_vector_type(8)));
typedef float f32x4 __attribute__((ext_vector_type(4)));
typedef unsigned u32x4 __attribute__((ext_vector_type(4)));
constexpr int BM = 256, BK = 64, HALF = 128, HTB = HALF * BK * 2  , STAGE_BYTES = 8 * HTB, NXCD = 8, WGM = 8;

__host__ __device__ __forceinline__ int lds_byte(int r, int c) { const int st = (r >> 4) * 2 + (c >> 5), rr = r & 15, cc = c & 31, ob = rr * 64 + cc * 2; return st * 1024 + (ob ^ (((ob >> 9) & 1) << 5)); }
__host__ __device__ __forceinline__ void stage_rc(int b, int& R, int& C) { const int st = b / 1024, sb = b % 1024, swz = sb ^ (((sb >> 9) & 1) << 5); R = (st >> 1) * 16 + swz / 64; C = (st & 1) * 32 + (swz % 64) / 2; }
__host__ __device__ __forceinline__ int perm32(int rho) { const int n = rho >> 4, i = rho & 15; return 8 * (i >> 2) + 4 * n + (i & 3); }

struct Unit { int pm, pn, seg; };
struct Gemm { const bf16_t* A; const bf16_t* Bt; int M, N, K; const bf16_t* A1; const bf16_t* Bt1; };

struct StaticOrder {
    int nM, nN, nwg, G, c;
    __host__ __device__ void init(int M, int N, int G_, int c_) { nM = M / BM; nN = N / BM; nwg = nM * nN; G = G_; c = c_; }
    __host__ __device__ bool next(int i, Unit& u) const {
        const long L = (long)i * G + c; if (L >= nwg) return false;
        int wgid = (int)L; { const int q = nwg / NXCD, r = nwg % NXCD, xcd = wgid % NXCD, off = wgid / NXCD; wgid = (xcd < r ? xcd * (q + 1) : r * (q + 1) + (xcd - r) * q) + off; }
        const int nig = WGM * nN, gid = wgid / nig, fm = gid * WGM, gsz = (nM - fm) < WGM ? (nM - fm) : WGM;
        u.pm = fm + ((wgid % nig) % gsz); u.pn = (wgid % nig) / gsz; u.seg = 0; return true;
    }
    __device__ __forceinline__ void a_ready(const Unit&) const {}
    __device__ __forceinline__ void done(const Unit&) const {}
};

__device__ __forceinline__ unsigned cvt_pk_bf16(float lo, float hi) { unsigned r; asm volatile("v_cvt_pk_bf16_f32 %0, %1, %2" : "=v"(r) : "v"(lo), "v"(hi)); return r; }
typedef float f32x2 __attribute__((ext_vector_type(2)));
__device__ __forceinline__ f32x2 gelu_pk(f32x2 v) {
    const f32x2 av = __builtin_elementwise_abs(v), d = av * 0.2316418882f + 1.0f;
    f32x2 t; t.x = __builtin_amdgcn_rcpf(d.x); t.y = __builtin_amdgcn_rcpf(d.y);
    f32x2 q = t * 0.5307027145f + (-0.7265760135f); q = q * t + 0.7107068705f; q = q * t + (-0.142248368f); q = q * t + 0.127414796f; q = q * t;
    const f32x2 s = (v * v) * (-0.72134752044f);
    f32x2 e; e.x = __builtin_amdgcn_exp2f(s.x); e.y = __builtin_amdgcn_exp2f(s.y);
    const f32x2 m = v * (q * e), r = v - m;
    f32x2 o; o.x = v.x < 0.f ? m.x : r.x; o.y = v.y < 0.f ? m.y : r.y; return o;
}

template <class Epi, class Sched, bool ALIGN_EPI = false, bool SP2 = false>
__device__ __forceinline__ void gemm_phase(PG8_LAS unsigned char* lds, const Gemm g, const Sched& S, const Epi& E, const int wave0) {
    int lane_; asm volatile("v_mbcnt_lo_u32_b32 %0, -1, 0\n\tv_mbcnt_hi_u32_b32 %0, -1, %0" : "=v"(lane_)); const int tid = wave0 * 64 + lane_, wid = wave0, lane = tid & 63, wr = wid >> 2, wc = wid & 3, fr = lane & 15, fq = lane >> 4;
    const int K = g.K, nt = K / BK;
    unsigned voffA[2], voffB[2];
#pragma unroll
    for (int i = 0; i < 2; ++i) { int R, C; stage_rc(tid * 16 + i * 8192, R, C); const int Rb = Epi::PERM ? ((R & ~31) + perm32(R & 31)) : R;
        voffA[i] = (unsigned)(R * K + C) * 2u; voffB[i] = (unsigned)(Rb * K + C) * 2u; }
    const size_t kstep = (size_t)(BK * 2);
    const size_t hstep = (size_t)HALF * K * 2;
    const size_t tstep = 2 * hstep;
    const unsigned ldsw = (unsigned)wid * 1024u;
    const int aoff = lds_byte(wr * 64 + fr, fq * 8), boff = lds_byte(wc * 32 + fr, fq * 8);
#define PG8_SA(b, h) (((b) * 2 + (h)) * HTB)
#define PG8_SB(b, h) ((4 + (b) * 2 + (h)) * HTB)
#define PG8_STAGE(bufoff, gbase, voff) do { _Pragma("unroll") for (int _i = 0; _i < 2; ++_i) \
        __builtin_amdgcn_global_load_lds((const unsigned*)((const char*)(gbase) + (voff)[_i]), (PG8_LAS unsigned*)(lds + (bufoff) + ldsw + _i * 8192), 16, 0, 0); } while (0)
#define PG8_LDA(dst, b, h) do { _Pragma("unroll") for (int m = 0; m < 4; ++m) _Pragma("unroll") for (int k = 0; k < 2; ++k) dst[m][k] = *(const PG8_LAS bf16x8*)(lds + PG8_SA(b, h) + aoff + m * 2048 + k * 1024); } while (0)
#define PG8_LDB(dst, b, h) do { _Pragma("unroll") for (int n = 0; n < 2; ++n) _Pragma("unroll") for (int k = 0; k < 2; ++k) dst[n][k] = *(const PG8_LAS bf16x8*)(lds + PG8_SB(b, h) + boff + n * 2048 + k * 1024); } while (0)
#define PG8_MMA(ai, bj, At, Bt) do { __builtin_amdgcn_s_setprio(1); _Pragma("unroll") for (int m = 0; m < 4; ++m) _Pragma("unroll") for (int n = 0; n < 2; ++n) _Pragma("unroll") for (int k = 0; k < 2; ++k) \
        acc[ai][bj][m][n] = __builtin_amdgcn_mfma_f32_16x16x32_bf16(Bt[n][k], At[m][k], acc[ai][bj][m][n], 0, 0, 0); __builtin_amdgcn_s_setprio(0); } while (0)
#define PG8_WAIT_V(n) asm volatile("s_waitcnt vmcnt(" #n ")" ::: "memory")
#define PG8_WAIT_L(n) asm volatile("s_waitcnt lgkmcnt(" #n ")" ::: "memory")
#define PG8_BAR __builtin_amdgcn_s_barrier()
#define PG8_SCHED __builtin_amdgcn_sched_barrier(0)
    Unit cur, nxt; int ui = 0;
    if (!S.next(0, cur)) return;
    f32x4 acc[2][2][4][2];
#pragma unroll
    for (int a = 0; a < 2; ++a)
#pragma unroll
        for (int b = 0; b < 2; ++b)
#pragma unroll
            for (int m = 0; m < 4; ++m)
#pragma unroll
                for (int n = 0; n < 2; ++n) acc[a][b][m][n] = (f32x4){0.f, 0.f, 0.f, 0.f};
    bf16x8 At[4][2], B0[2][2], B1[2][2];
    const char* cA = (const char*)(cur.seg ? g.A1 : g.A) + (size_t)cur.pm * tstep; const char* cB = (const char*)(cur.seg ? g.Bt1 : g.Bt) + (size_t)cur.pn * tstep;
    S.a_ready(cur);
    if constexpr (SP2) {
        PG8_STAGE(PG8_SB(0, 0), cB, voffB); PG8_STAGE(PG8_SB(0, 1), cB + hstep, voffB); PG8_STAGE(PG8_SA(0, 0), cA, voffA); PG8_STAGE(PG8_SA(0, 1), cA + hstep, voffA);
        if (wr == 1) PG8_BAR;
        PG8_WAIT_V(2); PG8_BAR;
        PG8_STAGE(PG8_SB(1, 0), cB + kstep, voffB); PG8_STAGE(PG8_SA(1, 0), cA + kstep, voffA); PG8_STAGE(PG8_SB(1, 1), cB + hstep + kstep, voffB);
        PG8_WAIT_V(6); PG8_BAR;
    } else {
        PG8_STAGE(PG8_SB(0, 0), cB, voffB); PG8_STAGE(PG8_SA(0, 0), cA, voffA); PG8_STAGE(PG8_SB(0, 1), cB + hstep, voffB); PG8_STAGE(PG8_SA(0, 1), cA + hstep, voffA);
        if (wr == 1) PG8_BAR;
        PG8_WAIT_V(4); PG8_BAR;
        PG8_STAGE(PG8_SB(1, 0), cB + kstep, voffB); PG8_STAGE(PG8_SA(1, 0), cA + kstep, voffA); PG8_STAGE(PG8_SB(1, 1), cB + hstep + kstep, voffB);
        PG8_WAIT_V(6); PG8_BAR;
    }
    for (;;) {
        const bool has_next = S.next(ui + 1, nxt);
        const char* nA = has_next ? (const char*)(nxt.seg ? g.A1 : g.A) + (size_t)nxt.pm * tstep : cA; const char* nB = has_next ? (const char*)(nxt.seg ? g.Bt1 : g.Bt) + (size_t)nxt.pn * tstep : cB;
        for (int t = 0; t < nt; t += 2) {
            const bool last = (t == nt - 2);
            const char* a1 = cA + (size_t)(t + 1) * kstep;
            const char* a2 = last ? nA : cA + (size_t)(t + 2) * kstep; const char* b2 = last ? nB : cB + (size_t)(t + 2) * kstep;
            const char* a3 = a2 + kstep; const char* b3 = b2 + kstep;
            if (last && has_next) S.a_ready(nxt);
            if constexpr (SP2) {
            PG8_LDB(B0, 0, 0); PG8_LDB(B1, 0, 1); PG8_SCHED; PG8_LDA(At, 0, 0); PG8_STAGE(PG8_SA(1, 1), a1 + hstep, voffA);
            PG8_WAIT_V(8); PG8_WAIT_L(0); PG8_BAR; PG8_MMA(0, 0, At, B0); PG8_MMA(0, 1, At, B1); PG8_BAR; PG8_SCHED;
            PG8_LDA(At, 0, 1); PG8_STAGE(PG8_SB(0, 0), b2, voffB); PG8_STAGE(PG8_SB(0, 1), b2 + hstep, voffB); PG8_STAGE(PG8_SA(0, 0), a2, voffA);
            PG8_WAIT_V(8); PG8_WAIT_L(0); PG8_BAR; PG8_MMA(1, 0, At, B0); PG8_MMA(1, 1, At, B1); PG8_BAR; PG8_SCHED;
            PG8_LDB(B0, 1, 0); PG8_LDB(B1, 1, 1); PG8_SCHED; PG8_LDA(At, 1, 0); PG8_STAGE(PG8_SA(0, 1), a2 + hstep, voffA);
            PG8_WAIT_V(8); PG8_WAIT_L(0); PG8_BAR; PG8_MMA(0, 0, At, B0); PG8_MMA(0, 1, At, B1); PG8_BAR; PG8_SCHED;
            PG8_LDA(At, 1, 1); PG8_STAGE(PG8_SB(1, 0), b3, voffB); PG8_STAGE(PG8_SB(1, 1), b3 + hstep, voffB); PG8_STAGE(PG8_SA(1, 0), a3, voffA);
            PG8_WAIT_V(8); PG8_WAIT_L(0); PG8_BAR; PG8_MMA(1, 0, At, B0); PG8_MMA(1, 1, At, B1); PG8_BAR; PG8_SCHED;
            } else {
            PG8_LDB(B0, 0, 0); PG8_SCHED; PG8_LDA(At, 0, 0); PG8_STAGE(PG8_SA(1, 1), a1 + hstep, voffA);
            PG8_WAIT_L(8); PG8_BAR; PG8_WAIT_L(0); PG8_MMA(0, 0, At, B0); PG8_BAR; PG8_SCHED;
            PG8_LDB(B1, 0, 1); PG8_STAGE(PG8_SB(0, 0), b2, voffB);
            PG8_BAR; PG8_WAIT_L(0); PG8_MMA(0, 1, At, B1); PG8_BAR;
            PG8_LDA(At, 0, 1); PG8_STAGE(PG8_SA(0, 0), a2, voffA);
            PG8_BAR; PG8_WAIT_L(0); PG8_MMA(1, 0, At, B0); PG8_BAR; PG8_SCHED;
            PG8_STAGE(PG8_SB(0, 1), b2 + hstep, voffB);
            PG8_WAIT_V(6); PG8_BAR; PG8_MMA(1, 1, At, B1); PG8_BAR;
            PG8_LDB(B0, 1, 0); PG8_SCHED; PG8_LDA(At, 1, 0); PG8_STAGE(PG8_SA(0, 1), a2 + hstep, voffA);
            PG8_WAIT_L(8); PG8_BAR; PG8_WAIT_L(0); PG8_MMA(0, 0, At, B0); PG8_BAR; PG8_SCHED;
            PG8_LDB(B1, 1, 1); PG8_STAGE(PG8_SB(1, 0), b3, voffB);
            PG8_BAR; PG8_WAIT_L(0); PG8_MMA(0, 1, At, B1); PG8_BAR;
            PG8_LDA(At, 1, 1); PG8_STAGE(PG8_SA(1, 0), a3, voffA);
            PG8_BAR; PG8_WAIT_L(0); PG8_MMA(1, 0, At, B0); PG8_BAR; PG8_SCHED;
            PG8_STAGE(PG8_SB(1, 1), b3 + hstep, voffB);
            PG8_WAIT_V(6); PG8_BAR; PG8_MMA(1, 1, At, B1); PG8_BAR;
            }
        }
        if constexpr (ALIGN_EPI) { if (wr == 0) PG8_BAR; }
        if constexpr (!Epi::AFTER_DRAIN) { E(acc, cur, wr, wc, fr, fq); S.done(cur); }
        if (!has_next) break;
#pragma unroll
        for (int a = 0; a < 2; ++a)
#pragma unroll
            for (int b = 0; b < 2; ++b)
#pragma unroll
                for (int m = 0; m < 4; ++m)
#pragma unroll
                    for (int n = 0; n < 2; ++n) acc[a][b][m][n] = (f32x4){0.f, 0.f, 0.f, 0.f};
        cur = nxt; cA = nA; cB = nB; ++ui;
        if constexpr (ALIGN_EPI) { if (wr == 1) PG8_BAR; }
    }
    PG8_WAIT_V(0);
    if constexpr (!ALIGN_EPI) { if (wr == 0) PG8_BAR; }
    PG8_BAR;
    if constexpr (Epi::AFTER_DRAIN) { E.fused(acc, cur, wr, wc, fr, fq, lds, wid, lane); S.done(cur); }
#undef PG8_SA
#undef PG8_SB
#undef PG8_STAGE
#undef PG8_LDA
#undef PG8_LDB
#undef PG8_MMA
#undef PG8_WAIT_V
#undef PG8_WAIT_L
#undef PG8_BAR
#undef PG8_SCHED
}
}
namespace attn_body {
using bf16=__hip_bfloat16;
using bf16x8=__attribute__((ext_vector_type(8)))short;
using s16x4=__attribute__((ext_vector_type(4)))short;
using f32x16=__attribute__((ext_vector_type(16)))float;
using u32x4=__attribute__((ext_vector_type(4)))unsigned;
constexpr int BATCH=8,NHEAD=16,SEQ=2048,D=64,DM=NHEAD*D;
constexpr int NW=8,QBLK=32,QB=QBLK*NW,KVBLK=64,NQB=SEQ/QB;
constexpr int ATTN_PITCH=DM, ATTN_UNIT_ROWS=QB;
__device__ __forceinline__ int crow(int r,int hi){return (r&3)+8*(r>>2)+4*hi;}
#define SBAR() __builtin_amdgcn_sched_barrier(0)
__device__ __forceinline__ void cmask(f32x16&p0,f32x16&p1,int jb,int qrel,int hi){
  const float NEG=-INFINITY; int kb=64*jb+4*hi;
  #pragma unroll
  for(int r=0;r<16;++r){int kv=kb+(r&3)+8*(r>>2); if(kv>qrel)p0[r]=NEG; if(kv+32>qrel)p1[r]=NEG;}
}

constexpr int NSLOT=3, SLOTB=8192;
constexpr int LDS_K=0, LDS_V=NSLOT*SLOTB, LDS_WS=2*NSLOT*SLOTB, LDS_OST=LDS_WS+NW*64*4, LDS_CUM=LDS_OST+NW*4096, LDS_BYTES=LDS_CUM+SEQ*4;
constexpr float C2=0.125f*1.4426950408889634f;
__device__ __forceinline__ void glds16(const void*gsrc,unsigned lds_dst){unsigned keep;
  asm volatile("s_mov_b32 %0, m0\n\ts_mov_b32 m0, %2\n\ts_nop 0\n\tglobal_load_lds_dwordx4 %1, off\n\ts_mov_b32 m0, %0":"=&s"(keep):"v"(gsrc),"s"(lds_dst):"memory");}
__device__ __forceinline__ float max3f(float a,float b,float c){float r;asm("v_max3_f32 %0, %1, %2, %3":"=v"(r):"v"(a),"v"(b),"v"(c));return r;}
__device__ __forceinline__ float max2f(float a,float b){float r;asm("v_max_f32_e32 %0, %1, %2":"=v"(r):"v"(a),"v"(b));return r;}
__device__ __forceinline__ float fadd_s(float a,float b){float r;asm("v_add_f32_e32 %0, %1, %2":"=v"(r):"v"(a),"v"(b));return r;}
__device__ __forceinline__ float fsub_s(float a,float b){float r;asm("v_sub_f32_e32 %0, %1, %2":"=v"(r):"v"(a),"v"(b));return r;}
typedef float f32x2_t __attribute__((ext_vector_type(2))); typedef __bf16 bf16x2_t __attribute__((ext_vector_type(2)));
__device__ __forceinline__ unsigned cvtpk_s(float lo,float hi){f32x2_t v={lo,hi};bf16x2_t b=__builtin_convertvector(v,bf16x2_t);return __builtin_bit_cast(unsigned,b);}
#define WAIT_BAR(N) asm volatile("s_waitcnt vmcnt(" #N ") lgkmcnt(0)\n\ts_barrier":::"memory")

__device__ __forceinline__ void qkt(f32x16&p0,f32x16&p1,const char*Kslot,const bf16x8*qr,int r32,int hi){
  const char*kb=Kslot+hi*1024+r32*16;
  #pragma unroll
  for(int d0=0;d0<4;++d0){
    const bf16x8 b0=*reinterpret_cast<const bf16x8*>(kb+d0*2048);
    const bf16x8 b1=*reinterpret_cast<const bf16x8*>(kb+d0*2048+512);
    {p0=__builtin_amdgcn_mfma_f32_32x32x16_bf16(b0,qr[d0],p0,0,0,0);p1=__builtin_amdgcn_mfma_f32_32x32x16_bf16(b1,qr[d0],p1,0,0,0);}}
}
typedef __attribute__((address_space(3))) const char* lds_cptr;
typedef short v4i16_t __attribute__((ext_vector_type(4)));
__device__ __forceinline__ void kload8(bf16x8*kf,lds_cptr kp){
  kf[0]=*(const __attribute__((address_space(3))) bf16x8*)(kp);      kf[1]=*(const __attribute__((address_space(3))) bf16x8*)(kp+512);
  kf[2]=*(const __attribute__((address_space(3))) bf16x8*)(kp+2048); kf[3]=*(const __attribute__((address_space(3))) bf16x8*)(kp+2560);
  kf[4]=*(const __attribute__((address_space(3))) bf16x8*)(kp+4096); kf[5]=*(const __attribute__((address_space(3))) bf16x8*)(kp+4608);
  kf[6]=*(const __attribute__((address_space(3))) bf16x8*)(kp+6144); kf[7]=*(const __attribute__((address_space(3))) bf16x8*)(kp+6656);
}
__device__ __forceinline__ void kload2(bf16x8*kf,lds_cptr kp,int j){ kf[2*j]=*(const __attribute__((address_space(3))) bf16x8*)(kp+j*2048); kf[2*j+1]=*(const __attribute__((address_space(3))) bf16x8*)(kp+j*2048+512); }
__device__ __forceinline__ s16x4 vtr(lds_cptr p){ return __builtin_bit_cast(s16x4,__builtin_amdgcn_ds_read_tr16_b64_v4i16((__attribute__((address_space(3))) v4i16_t*)p)); }
__device__ __forceinline__ float rowmax(const f32x16&p0,const f32x16&p1){
  float a=max3f(p0[0],p0[1],p1[0]),b=max3f(p0[2],p0[3],p1[1]);a=max3f(a,p1[2],p1[3]);
  #pragma unroll
  for(int r=4;r<16;r+=4){a=max3f(a,p0[r],p0[r+1]);b=max3f(b,p0[r+2],p0[r+3]);a=max3f(a,p1[r],p1[r+1]);b=max3f(b,p1[r+2],p1[r+3]);}
  const float m=max2f(a,b);
  auto rr=__builtin_amdgcn_permlane32_swap(__float_as_uint(m),__float_as_uint(m),false,false);
  return max2f(__uint_as_float(rr[0]),__uint_as_float(rr[1]));
}
__device__ __forceinline__ void pv(f32x16*o,int vb,bf16x8 pa0,bf16x8 pa1,bf16x8 pa2,bf16x8 pa3){
  #pragma unroll
  for(int d0=0;d0<2;++d0){s16x4 lo[4],hi[4];
    #pragma unroll
    for(int ks=0;ks<4;++ks){
      asm volatile("ds_read_b64_tr_b16 %0,%1 offset:%c2":"=&v"(lo[ks]):"v"(vb),"i"(d0*4096+ks*1024):"memory");
      asm volatile("ds_read_b64_tr_b16 %0,%1 offset:%c2":"=&v"(hi[ks]):"v"(vb),"i"(d0*4096+ks*1024+512):"memory");}
    asm volatile("s_waitcnt lgkmcnt(0)":::"memory");SBAR();
    #define PK(k) (bf16x8){lo[k][0],lo[k][1],lo[k][2],lo[k][3],hi[k][0],hi[k][1],hi[k][2],hi[k][3]}
    o[d0]=__builtin_amdgcn_mfma_f32_32x32x16_bf16(pa0,PK(0),o[d0],0,0,0);
    o[d0]=__builtin_amdgcn_mfma_f32_32x32x16_bf16(pa1,PK(1),o[d0],0,0,0);
    o[d0]=__builtin_amdgcn_mfma_f32_32x32x16_bf16(pa2,PK(2),o[d0],0,0,0);
    o[d0]=__builtin_amdgcn_mfma_f32_32x32x16_bf16(pa3,PK(3),o[d0],0,0,0);
    #undef PK
  }
}

#ifndef ATTN_STORE16
#define ATTN_STORE16(p,v) (*(u32x4*)(p)=(v))
#endif
typedef float f32x4v __attribute__((ext_vector_type(4)));
template<int THRL> __device__ __forceinline__ void attn_unit(int b,int h,int qb,const bf16*Q,const bf16*__restrict__ K,const bf16*__restrict__ V,bf16*O,const float*__restrict__ CUMG,char*shm,const int wave0){
  int lane_; asm volatile("v_mbcnt_lo_u32_b32 %0, -1, 0\n\tv_mbcnt_hi_u32_b32 %0, -1, %0":"=v"(lane_)); const int wid=wave0,tid=wave0*64+lane_,lane=lane_,r32=lane&31,hi=lane>>5;
  const long rowbase=(long)b*SEQ; const int q0=qb*QB;
  const bf16*Qw=Q+(rowbase+q0+wid*QBLK)*DM+h*D;
  const bf16*Kh=K+rowbase*DM+h*D,*Vh=V+rowbase*DM+h*D;
  const unsigned lds0=(unsigned)(uintptr_t)shm;
  float*wsf=(float*)(shm+LDS_WS)+wid*64;
  const bf16*ksrc=Kh+(long)lane*DM+wid*8;
  const bf16*vsrc=Vh+(long)(16*(wid&3)+(lane>>2))*DM+(wid>>2)*32+(lane&3)*8;
  const unsigned kdst=lds0+LDS_K+wid*1024, vdst=lds0+LDS_V+wid*1024;
  #define DMA_K(t,slot) glds16(ksrc+(long)(t)*KVBLK*DM,(unsigned)__builtin_amdgcn_readfirstlane(kdst+(slot)))
  #define DMA_V(t,slot) glds16(vsrc+(long)(t)*KVBLK*DM,(unsigned)__builtin_amdgcn_readfirstlane(vdst+(slot)))
  const int vb0=(int)(lds0+LDS_V)+((lane>>4)&1)*32+(lane&3)*8+(4*hi+((lane&15)>>2))*64;
  const char*Kbase=shm+LDS_K; bf16x8 kf[8];
  const lds_cptr shm3=(lds_cptr)shm; const lds_cptr kp0=shm3+LDS_K+hi*1024+r32*16; const lds_cptr vp0=shm3+LDS_V+((lane>>4)&1)*32+(lane&3)*8+(4*hi+((lane&15)>>2))*64;
  const int NT=(q0+QB)/KVBLK;
  DMA_K(0,0);DMA_V(0,0);DMA_K(1,SLOTB);
  bf16x8 qr[4];
  #pragma unroll
  for(int d0=0;d0<4;++d0)qr[d0]=*reinterpret_cast<const bf16x8*>(&Qw[(long)r32*DM+d0*16+hi*8]);
  { float*cl=(float*)(shm+LDS_CUM); for(int i_=tid;i_<q0+QB;i_+=NW*64)cl[i_]=CUMG[i_]; }
  const float cq=CUMG[q0+wid*QBLK+r32]; float nm=cq;
  const __attribute__((address_space(3))) float* cl3=(const __attribute__((address_space(3))) float*)((lds_cptr)shm+LDS_CUM);
  #define CKLOAD(P0,P1,t) do{ const __attribute__((address_space(3))) float* cb_=cl3+(t)*64+4*hi; \
    _Pragma("unroll") for(int g_=0;g_<4;++g_){ const f32x4v c0_=*(const __attribute__((address_space(3))) f32x4v*)(cb_+8*g_), c1_=*(const __attribute__((address_space(3))) f32x4v*)(cb_+32+8*g_); \
      _Pragma("unroll") for(int j_=0;j_<4;++j_){ P0[4*g_+j_]=c0_[j_]; P1[4*g_+j_]=c1_[j_]; } } }while(0)
  #define CKINIT(P0,P1) do{ _Pragma("unroll") for(int r=0;r<16;++r){P0[r]=nm-P0[r];P1[r]=nm-P1[r];} }while(0)
  float mhat=0.f,l_reg=0.f;f32x16 o[2];o[0]=f32x16{};o[1]=f32x16{};
  const int qrel=wid*QBLK+r32;
  #define CMASK(P0,P1,t) do{int jb_=(t)-(NT-4); if(jb_>=0)cmask(P0,P1,jb_,qrel,hi);}while(0)
  bool resc=false;
  #define START(P0,P1) do{ const float rm=rowmax(P0,P1); resc=false; \
    { const float dl=rm; mhat=fadd_s(mhat,dl); \
      _Pragma("unroll") for(int r=0;r<16;++r){P0[r]=fsub_s(P0[r],dl);P1[r]=fsub_s(P1[r],dl);} \
      nm=cq-mhat; } \
    _Pragma("unroll") for(int r=0;r<16;++r)P0[r]=__builtin_amdgcn_exp2f(P0[r]); }while(0)
  #define RESC() do{ if(resc){ asm volatile("s_waitcnt lgkmcnt(0)":::"memory"); \
      _Pragma("unroll") for(int d_=0;d_<2;++d_) _Pragma("unroll") for(int r=0;r<16;++r)o[d_][r]*=wsf[crow(r,hi)]; } }while(0)
  f32x16 pA0,pA1,pB0,pB1;
  int sl_prev=0,sl_cur=0,sl_next=SLOTB;
  #define ROT() do{sl_prev=sl_cur;sl_cur=sl_next;sl_next=(sl_next==(NSLOT-1)*SLOTB)?0:sl_next+SLOTB;}while(0)
  DMA_K(2,2*SLOTB);
  WAIT_BAR(3);
  CKLOAD(pA0,pA1,0);CKINIT(pA0,pA1);qkt(pA0,pA1,Kbase,qr,r32,hi);asm volatile("s_nop 15\n\ts_nop 7":"+v"(pA0),"+v"(pA1));CMASK(pA0,pA1,0);
  START(pA0,pA1);
  CKLOAD(pB0,pB1,1);
  _Pragma("unroll") for(int r=0;r<16;++r)pA1[r]=__builtin_amdgcn_exp2f(pA1[r]);
  WAIT_BAR(0);
  DMA_K(3,0);DMA_V(1,SLOTB);
  ROT();
  kload8(kf,kp0+sl_cur);
  WAIT_BAR(2);
  s16x4 vlo[8],vhi[8]; u32x4 pw0,pw1,pw2,pw3;
  #define PKW(P,B) cvtpk_s(P[B],P[B+1])
  #define PAF(k) __builtin_bit_cast(bf16x8,pw##k)
  #define VFR(i) (bf16x8){vlo[i][0],vlo[i][1],vlo[i][2],vlo[i][3],vhi[i][0],vhi[i][1],vhi[i][2],vhi[i][3]}
  #define PIN(x) asm volatile("":"+v"(x))
  #define MX3(a,b,c) __builtin_fmaxf(__builtin_fmaxf((a),(b)),(c))
  #define GAPA(MF,A0,A1,A2,A3,W0,W1,PW) do{ MF; sacc+=A0; sacc+=A1; sacc+=A2; sacc+=A3; PIN(sacc); W0; W1; PIN(PW); SBAR(); }while(0)
  #define EX(v) __builtin_amdgcn_exp2f(v)
  #define GAPB(MF,X,B) do{ MF; X[B]=EX(X[B]); X[B+1]=EX(X[B+1]); X[B+2]=EX(X[B+2]); X[B+3]=EX(X[B+3]); PIN(X); SBAR(); }while(0)
  #define VRD(i) do{ vlo[i]=vtr(vp_+(((i)>>2)*4096+((i)&3)*1024)); vhi[i]=vtr(vp_+(((i)>>2)*4096+((i)&3)*1024+512)); }while(0)
  #define KRD(G,j) do{ if(G){ kload2(kf,kp0+sl_next,j); SBAR(); } }while(0)
  #define STEP(C0,C1,P0,P1,t,GK,GV,GL) do{ SBAR(); CKINIT(C0,C1); \
    const lds_cptr vp_=vp0+sl_prev; \
    VRD(0); SBAR(); float sacc=(P0[0]+P0[1]); \
    GAPA(C0=__builtin_amdgcn_mfma_f32_32x32x16_bf16(kf[0],qr[0],C0,0,0,0), P0[2],P0[3],P0[4],P0[5],     pw0[0]=PKW(P0,0), pw0[1]=PKW(P0,2), pw0); \
    VRD(4); SBAR(); GAPA(C1=__builtin_amdgcn_mfma_f32_32x32x16_bf16(kf[1],qr[0],C1,0,0,0), P0[6],P0[7],P0[8],P0[9],     pw0[2]=PKW(P0,4), pw0[3]=PKW(P0,6), pw0); \
    VRD(1); SBAR(); GAPA(C0=__builtin_amdgcn_mfma_f32_32x32x16_bf16(kf[2],qr[1],C0,0,0,0),   P0[10],P0[11],P0[12],P0[13], pw1[0]=PKW(P0,8), pw1[1]=PKW(P0,10), pw1); \
    VRD(5); SBAR(); GAPA(C1=__builtin_amdgcn_mfma_f32_32x32x16_bf16(kf[3],qr[1],C1,0,0,0),   P0[14],P0[15],P1[0],P1[1],   pw1[2]=PKW(P0,12),pw1[3]=PKW(P0,14), pw1); \
    VRD(2); SBAR(); GAPA(C0=__builtin_amdgcn_mfma_f32_32x32x16_bf16(kf[4],qr[2],C0,0,0,0),   P1[2],P1[3],P1[4],P1[5],     pw2[0]=PKW(P1,0), pw2[1]=PKW(P1,2), pw2); \
    VRD(6); SBAR(); GAPA(C1=__builtin_amdgcn_mfma_f32_32x32x16_bf16(kf[5],qr[2],C1,0,0,0),   P1[6],P1[7],P1[8],P1[9],     pw2[2]=PKW(P1,4), pw2[3]=PKW(P1,6), pw2); \
    VRD(3); SBAR(); GAPA(C0=__builtin_amdgcn_mfma_f32_32x32x16_bf16(kf[6],qr[3],C0,0,0,0),   P1[10],P1[11],P1[12],P1[13], pw3[0]=PKW(P1,8), pw3[1]=PKW(P1,10), pw3); \
    VRD(7); SBAR(); GAPA(C1=__builtin_amdgcn_mfma_f32_32x32x16_bf16(kf[7],qr[3],C1,0,0,0),   P1[14],P1[15],0.f,0.f,       pw3[2]=PKW(P1,12),pw3[3]=PKW(P1,14), pw3); \
    l_reg+=sacc; \
    if(GK){DMA_K((t)+3,sl_cur);} if(GV){DMA_V((t)+1,sl_next);} \
    CMASK(C0,C1,t); \
    { float a=MX3(C0[0],C0[1],C1[0]),b=MX3(C0[2],C0[3],C1[1]); a=MX3(a,C1[2],C1[3]); \
      _Pragma("unroll") for(int r=4;r<16;r+=4){a=MX3(a,C0[r],C0[r+1]);b=MX3(b,C0[r+2],C0[r+3]);a=MX3(a,C1[r],C1[r+1]);b=MX3(b,C1[r+2],C1[r+3]);} \
      float rm=__builtin_fmaxf(a,b); { auto rr=__builtin_amdgcn_permlane32_swap(__float_as_uint(rm),__float_as_uint(rm),false,false); rm=__builtin_fmaxf(__uint_as_float(rr[0]),__uint_as_float(rr[1])); } \
      resc=false; \
      if(__builtin_expect(__any(rm>(float)THRL),0)){ const float dl=__builtin_fmaxf(rm,0.f); mhat+=dl; \
        _Pragma("unroll") for(int r=0;r<16;++r){C0[r]-=dl;C1[r]-=dl;} \
        nm=cq-mhat; \
        const float f=__builtin_amdgcn_exp2f(-dl); l_reg*=f; if(hi==0)wsf[r32]=f; resc=true; } } \
    if(GL){ CKLOAD(P0,P1,(t)+1); } \
    SBAR(); \
    GAPB(o[0]=__builtin_amdgcn_mfma_f32_32x32x16_bf16(PAF(0),VFR(0),o[0],0,0,0), C0,0); \
    GAPB(o[1]=__builtin_amdgcn_mfma_f32_32x32x16_bf16(PAF(0),VFR(4),o[1],0,0,0), C0,4); \
    KRD(GL,0); GAPB(o[0]=__builtin_amdgcn_mfma_f32_32x32x16_bf16(PAF(1),VFR(1),o[0],0,0,0), C0,8); \
    KRD(GL,1); GAPB(o[1]=__builtin_amdgcn_mfma_f32_32x32x16_bf16(PAF(1),VFR(5),o[1],0,0,0), C0,12); \
    KRD(GL,2); GAPB(o[0]=__builtin_amdgcn_mfma_f32_32x32x16_bf16(PAF(2),VFR(2),o[0],0,0,0), C1,0); \
    KRD(GL,3); GAPB(o[1]=__builtin_amdgcn_mfma_f32_32x32x16_bf16(PAF(2),VFR(6),o[1],0,0,0), C1,4); \
    GAPB(o[0]=__builtin_amdgcn_mfma_f32_32x32x16_bf16(PAF(3),VFR(3),o[0],0,0,0), C1,8); \
    GAPB(o[1]=__builtin_amdgcn_mfma_f32_32x32x16_bf16(PAF(3),VFR(7),o[1],0,0,0), C1,12); \
    }while(0)
  int t=1;
  #undef CMASK
  #define CMASK(P0,P1,t) do{}while(0)
  for(;t+5<NT;t+=2){
    STEP(pB0,pB1,pA0,pA1,t,true,true,true);     WAIT_BAR(2); RESC(); ROT();
    STEP(pA0,pA1,pB0,pB1,t+1,true,true,true);   WAIT_BAR(2); RESC(); ROT();
  }
  #undef CMASK
  #define CMASK(P0,P1,t) do{int jb_=(t)-(NT-4); if(jb_>=0)cmask(P0,P1,jb_,qrel,hi);}while(0)
  #define ENDW(tt) do{ if((tt)+3<NT){WAIT_BAR(2);} else if((tt)+2<NT){WAIT_BAR(1);} else {WAIT_BAR(0);} }while(0)
  for(;t+1<NT;t+=2){
    STEP(pB0,pB1,pA0,pA1,t,(t+3<NT),(t+1<NT),(t+1<NT));       ENDW(t);   RESC(); ROT();
    STEP(pA0,pA1,pB0,pB1,t+1,(t+4<NT),(t+2<NT),(t+2<NT));     ENDW(t+1); RESC(); ROT();
  }
  STEP(pB0,pB1,pA0,pA1,NT-1,false,false,false); RESC();
  { float sacc=pB0[0]+pB0[1]; _Pragma("unroll") for(int r=2;r<16;++r)sacc+=pB0[r]; _Pragma("unroll") for(int r=0;r<16;++r)sacc+=pB1[r]; l_reg+=sacc;
    pw0=(u32x4){PKW(pB0,0),PKW(pB0,2),PKW(pB0,4),PKW(pB0,6)};pw1=(u32x4){PKW(pB0,8),PKW(pB0,10),PKW(pB0,12),PKW(pB0,14)};pw2=(u32x4){PKW(pB1,0),PKW(pB1,2),PKW(pB1,4),PKW(pB1,6)};pw3=(u32x4){PKW(pB1,8),PKW(pB1,10),PKW(pB1,12),PKW(pB1,14)};
    SBAR(); pv(o,vb0+sl_cur,PAF(0),PAF(1),PAF(2),PAF(3)); }
  #undef PKW
  #undef PAF
  #undef VFR
  #undef PIN
  #undef MX3
  #undef GAPA
  #undef GAPB
  #undef EX
  #undef VRD
  #undef KRD
  #undef STEP
  #undef ENDW
  {auto rr=__builtin_amdgcn_permlane32_swap(__float_as_uint(l_reg),__float_as_uint(l_reg),false,false);l_reg=__uint_as_float(rr[0])+__uint_as_float(rr[1]);}
  if(hi==0)wsf[32+r32]=l_reg;asm volatile("s_waitcnt lgkmcnt(0)":::"memory");
  float rli[16];
  #pragma unroll
  for(int r=0;r<16;++r)rli[r]=__builtin_amdgcn_rcpf(wsf[32+crow(r,hi)]);
  bf16*Ow=O+(rowbase+q0+wid*QBLK)*DM+h*D;
  { bf16*stg=(bf16*)(shm+LDS_OST)+wid*2048;
    #pragma unroll
    for(int r=0;r<16;++r){const int orow=crow(r,hi);
      #pragma unroll
      for(int d0=0;d0<2;++d0)stg[orow*64+d0*32+r32]=__float2bfloat16(o[d0][r]*rli[r]);}
    asm volatile("s_waitcnt lgkmcnt(0)":::"memory");
    #pragma unroll
    for(int i=0;i<4;++i){const int row=i*8+(lane>>3),ch=lane&7; const u32x4 v=*(const u32x4*)(stg+row*64+ch*8); ATTN_STORE16(Ow+(long)row*DM+ch*8,v);} }
  asm volatile("s_waitcnt lgkmcnt(0)\n\ts_barrier":::"memory");
  #undef DMA_K
  #undef DMA_V
  #undef CMASK
  #undef START
  #undef RESC
  #undef CKLOAD
  #undef CKINIT
  #undef ROT
}
constexpr int ATTN_LDS_BYTES=LDS_BYTES;
struct AttnTensors { const bf16* Q; const bf16* K; const bf16* V; bf16* O; const float* CUM; };
struct AttnUnit { int bh; int qb; };
struct StaticOrder {
  int vcu;
  __device__ __forceinline__ explicit StaticOrder(int grid,int block):vcu((block%8)*(grid/8)+block/8){}
  __device__ __forceinline__ bool next(int i,AttnUnit&u)const{ if(i>=4)return false; const int s=2*(vcu&1); u.bh=vcu>>1; u.qb=(i==0)?7-s:(i==1)?s:(i==2)?6-s:s+1; return true; }
  __device__ __forceinline__ void a_ready(const AttnUnit&)const{}
  __device__ __forceinline__ void done(const AttnUnit&)const{}
};
template<class Sched,int THRL=8> __device__ __forceinline__ void attn_phase(char*lds,const AttnTensors&T,const Sched&S,const int wave0){
  AttnUnit u;
  for(int i=0;S.next(i,u);++i){ S.a_ready(u); attn_unit<THRL>(u.bh/NHEAD,u.bh%NHEAD,u.qb,T.Q,T.K,T.V,T.O,T.CUM+(long)u.bh*SEQ,lds,wave0); S.done(u); }
}
#undef SBAR
#undef WAIT_BAR
}
namespace cg = cooperative_groups;
#define LAS __attribute__((address_space(3)))
typedef unsigned short bf16;
typedef unsigned v4u __attribute__((ext_vector_type(4)));
typedef unsigned v2u __attribute__((ext_vector_type(2)));
typedef float f32x4 __attribute__((ext_vector_type(4)));
typedef short bf16x8 __attribute__((ext_vector_type(8)));

constexpr int NWAVES = 8, NTHR = 512;
constexpr int M = 16384, DMODEL = 1024, SEQ = 2048, NBATCH = 8, NHEAD = 16, FF = 2816, NUP = 5632, PLED = 256, NIN = 7168, NINF = 7184;
constexpr float EPS = 1e-6f, LOG2E = 1.4426950408889634f;
constexpr size_t MiB = 1u << 20;
constexpr size_t WS_CTL = 0, WS_WIN = 1 * MiB, WS_WA = 15 * MiB, WS_WB = 17 * MiB, WS_WOUT = 19 * MiB, WS_WUP = 21 * MiB, WS_WDN = 32 * MiB,
                 WS_WPLE = 37 * MiB + 512 * 1024, WS_WPG = 38 * MiB, WS_WS = 40 * MiB, WS_LF = 41 * MiB, WS_CUM = 42 * MiB,
                 WS_SS1 = 43 * MiB, WS_SS2 = 43 * MiB + 256 * 1024, WS_SS3 = 43 * MiB + 512 * 1024,
                 WS_PB = 44 * MiB, WS_XN = 52 * MiB, WS_U = 84 * MiB, WS_V = 116 * MiB, WS_Q = 148 * MiB, WS_K = 180 * MiB, WS_VA = 212 * MiB, WS_END = 244 * MiB;
constexpr size_t WS_TMP = WS_K, WS_MRG = WS_V, WS_X1 = WS_K, WS_ACT = WS_U, WS_PLEB = WS_U;
constexpr int RING_BYTES = 131072, LDS_BYTES = 147456;

__device__ __forceinline__ unsigned f2bf(float f) { unsigned u = __builtin_bit_cast(unsigned, f); return (u + 0x7fffu + ((u >> 16) & 1u)) >> 16; }
__device__ __forceinline__ unsigned pk2(float lo, float hi) { return pg8::cvt_pk_bf16(lo, hi); }
__device__ __forceinline__ float bflo(unsigned w) { return __uint_as_float(w << 16); }
__device__ __forceinline__ float bfhi(unsigned w) { return __uint_as_float(w & 0xffff0000u); }
__device__ __forceinline__ float sigm(float x) { return __builtin_amdgcn_rcpf(1.0f + __builtin_amdgcn_exp2f(-LOG2E * x)); }
__device__ __forceinline__ float gelu_t(float x) { const float u = x * (1.5957691216f + 0.0713548163f * x * x); return x * __builtin_amdgcn_rcpf(1.0f + __builtin_amdgcn_exp2f(-LOG2E * u)); }
__device__ __forceinline__ float wave_sum(float v) {
#pragma unroll
    for (int o = 1; o < 64; o <<= 1) v += __shfl_xor(v, o);
    return v;
}
#define LDS_WAIT() asm volatile("s_waitcnt lgkmcnt(0)" ::: "memory")
#define VM_WAIT() asm volatile("s_waitcnt vmcnt(0)" ::: "memory")

__device__ __forceinline__ void transpose_item(const float* W, int Nsrc, int src_col0, int k0, bf16* WT, int K, int dst_row0, const float* kscale, LAS float* scr, int lane) {
#pragma unroll 8
    for (int i = 0; i < 32; ++i) { const int kk = 2 * i + (lane >> 5); float v = W[(size_t)(k0 + kk) * Nsrc + src_col0 + (lane & 31)]; if (kscale) v *= kscale[k0 + kk]; scr[kk * 33 + (lane & 31)] = v; }
    LDS_WAIT(); asm volatile("" ::: "memory");
    const int c = lane & 7;
#pragma unroll
    for (int j = 0; j < 4; ++j) { const int n = (lane >> 3) + 8 * j; const LAS float* s = scr + (8 * c) * 33 + n;
        v4u o; o.x = pk2(s[0 * 33], s[1 * 33]); o.y = pk2(s[2 * 33], s[3 * 33]); o.z = pk2(s[4 * 33], s[5 * 33]); o.w = pk2(s[6 * 33], s[7 * 33]);
        *(v4u*)(WT + (size_t)(dst_row0 + n) * K + k0 + 8 * c) = o; }
    LDS_WAIT(); asm volatile("" ::: "memory");
}

struct Args { const float* in[21]; float* out; unsigned char* ws; };

struct SegOrder {
    pg8::StaticOrder S; int nseg;
    __device__ bool next(int i, pg8::Unit& u) const { const bool ok = S.next(i / nseg, u); u.seg = i % nseg; return ok; }
    __device__ __forceinline__ void a_ready(const pg8::Unit&) const {}
    __device__ __forceinline__ void done(const pg8::Unit&) const {}
};

struct EpiIn {
    static constexpr bool PERM = true, AFTER_DRAIN = false;
    bf16* Z; bf16* G;
    __device__ __forceinline__ void operator()(const pg8::f32x4 (&acc)[2][2][4][2], const pg8::Unit& u, int wr, int wc, int fr, int fq) const {
        const int grp = u.pn >> 2;
        bf16* base = grp < 5 ? Z + (size_t)grp * M * 1024 : G + (size_t)(grp - 5) * M * 1024;
        const int row0 = u.pm * 256 + wr * 64 + fr, col0 = (u.pn & 3) * 256 + wc * 32 + 8 * fq;
#pragma unroll
        for (int ai = 0; ai < 2; ++ai)
#pragma unroll
            for (int m = 0; m < 4; ++m) { const unsigned ro = (unsigned)((row0 + ai * 128 + m * 16) * 1024 + col0) * 2u;
#pragma unroll
                for (int bj = 0; bj < 2; ++bj) { f32x4 v0 = acc[ai][bj][m][0], v1 = acc[ai][bj][m][1];
                    if (grp < 2) {
#pragma unroll
                        for (int j = 0; j < 4; ++j) { v0[j] = gelu_t(v0[j]); v1[j] = gelu_t(v1[j]); }
                    } else if (grp == 2) { v0 = v0 * attn_body::C2; v1 = v1 * attn_body::C2; }
                    else if (grp >= 5) {
#pragma unroll
                        for (int j = 0; j < 4; ++j) { v0[j] = sigm(v0[j]); v1[j] = sigm(v1[j]); }
                    }
                    v4u w; w.x = pk2(v0[0], v0[1]); w.y = pk2(v0[2], v0[3]); w.z = pk2(v1[0], v1[1]); w.w = pk2(v1[2], v1[3]);
                    *(v4u*)((char*)base + (size_t)(ro + (unsigned)(bj * 256))) = w; } }
    }
};

struct EpiMerge {
    static constexpr bool PERM = true, AFTER_DRAIN = false;
    const bf16* GA; const bf16* GB; float* TMP; bf16* MRG;
    __device__ __forceinline__ void operator()(const pg8::f32x4 (&acc)[2][2][4][2], const pg8::Unit& u, int wr, int wc, int fr, int fq) const {
        const int row0 = u.pm * 256 + wr * 64 + fr, col0 = u.pn * 256 + wc * 32 + 8 * fq;
        const bf16* gp = u.seg ? GB : GA;
#pragma unroll
        for (int ai = 0; ai < 2; ++ai)
#pragma unroll
            for (int m = 0; m < 4; ++m) { const unsigned off = (unsigned)((row0 + ai * 128 + m * 16) * 1024 + col0);
#pragma unroll
                for (int bj = 0; bj < 2; ++bj) { const v4u gw = *(const v4u*)((const char*)gp + (size_t)((off + bj * 128) * 2u));
                    f32x4 g0 = {bflo(gw.x), bfhi(gw.x), bflo(gw.y), bfhi(gw.y)}, g1 = {bflo(gw.z), bfhi(gw.z), bflo(gw.w), bfhi(gw.w)};
                    f32x4 v0 = acc[ai][bj][m][0] * g0, v1 = acc[ai][bj][m][1] * g1;
                    float* tp = (float*)((char*)TMP + (size_t)((off + bj * 128) * 4u));
                    if (u.seg == 0) { *(f32x4*)tp = v0; *(f32x4*)(tp + 4) = v1; }
                    else { v0 += *(const f32x4*)tp; v1 += *(const f32x4*)(tp + 4);
                        v4u w; w.x = pk2(v0[0], v0[1]); w.y = pk2(v0[2], v0[3]); w.z = pk2(v1[0], v1[1]); w.w = pk2(v1[2], v1[3]);
                        *(v4u*)((char*)MRG + (size_t)((off + bj * 128) * 2u)) = w; } } }
    }
};

struct EpiResid {
    static constexpr bool PERM = false, AFTER_DRAIN = true;
    const float* base; float* out; bf16* outb; float* SS;
    __device__ __forceinline__ void fused(pg8::f32x4 (&acc)[2][2][4][2], const pg8::Unit& u, int wr, int wc, int fr, int fq, PG8_LAS unsigned char* lds, int wid, int lane) const {
        PG8_LAS float* P = (PG8_LAS float*)lds;
        const int col0 = u.pn * 256 + wc * 32 + 4 * fq;
#pragma unroll
        for (int ai = 0; ai < 2; ++ai)
#pragma unroll
            for (int m = 0; m < 4; ++m) { const int r = ai * 128 + wr * 64 + m * 16 + fr; const size_t off = (size_t)(u.pm * 256 + r) * 1024 + col0; float q = 0.f;
#pragma unroll
                for (int bj = 0; bj < 2; ++bj)
#pragma unroll
                    for (int n = 0; n < 2; ++n) { const f32x4 o = *(const f32x4*)(base + off + bj * 128 + n * 16) + acc[ai][bj][m][n];
                        *(f32x4*)(out + off + bj * 128 + n * 16) = o; v2u w; w.x = pk2(o[0], o[1]); w.y = pk2(o[2], o[3]); *(v2u*)(outb + off + bj * 128 + n * 16) = w;
                        q += (o[0] * o[0] + o[1] * o[1]) + (o[2] * o[2] + o[3] * o[3]); }
                q += __shfl_xor(q, 16); q += __shfl_xor(q, 32);
                if (fq == 0) P[r * 4 + wc] = q;
                asm volatile("" ::: "memory"); }
        LDS_WAIT(); __builtin_amdgcn_s_barrier(); asm volatile("" ::: "memory");
        const int t = wid * 64 + lane;
        if (t < 256) { const f32x4 p = *(const PG8_LAS f32x4*)(P + t * 4); SS[(size_t)(u.pm * 256 + t) * 4 + u.pn] = (p[0] + p[1]) + (p[2] + p[3]); }
        LDS_WAIT(); __builtin_amdgcn_s_barrier(); asm volatile("" ::: "memory");
    }
};

struct EpiPlain {
    static constexpr bool PERM = false, AFTER_DRAIN = false;
    bf16* O;
    __device__ __forceinline__ void operator()(const pg8::f32x4 (&acc)[2][2][4][2], const pg8::Unit& u, int wr, int wc, int fr, int fq) const {
        const int col0 = u.pn * 256 + wc * 32 + 4 * fq;
#pragma unroll
        for (int ai = 0; ai < 2; ++ai)
#pragma unroll
            for (int m = 0; m < 4; ++m) { const size_t off = (size_t)(u.pm * 256 + ai * 128 + wr * 64 + m * 16 + fr) * 1024 + col0;
#pragma unroll
                for (int bj = 0; bj < 2; ++bj)
#pragma unroll
                    for (int n = 0; n < 2; ++n) { const f32x4 o = acc[ai][bj][m][n]; v2u w; w.x = pk2(o[0], o[1]); w.y = pk2(o[2], o[3]); *(v2u*)(O + off + bj * 128 + n * 16) = w; } }
    }
};

struct EpiPleGate {
    static constexpr bool PERM = false, AFTER_DRAIN = true;
    const float* base; const bf16* PLE; const float* SSin; float* out; float* SS;
    __device__ __forceinline__ void fused(pg8::f32x4 (&acc)[2][2][4][2], const pg8::Unit& u, int wr, int wc, int fr, int fq, PG8_LAS unsigned char* lds, int wid, int lane) const {
        PG8_LAS float* P = (PG8_LAS float*)lds;
        const int col0 = u.pn * 256 + wc * 32 + 4 * fq;
#pragma unroll
        for (int ai = 0; ai < 2; ++ai)
#pragma unroll
            for (int m = 0; m < 4; ++m) { const int r = ai * 128 + wr * 64 + m * 16 + fr; const size_t row = (size_t)(u.pm * 256 + r); const size_t off = row * 1024 + col0; float q = 0.f;
                const f32x4 s4 = *(const f32x4*)(SSin + row * 4); const float rstd = 1.0f / sqrtf(((s4[0] + s4[1]) + (s4[2] + s4[3])) * (1.0f / 1024.0f) + EPS);
#pragma unroll
                for (int bj = 0; bj < 2; ++bj)
#pragma unroll
                    for (int n = 0; n < 2; ++n) { const size_t o2 = off + bj * 128 + n * 16; const f32x4 b = *(const f32x4*)(base + o2); const v2u pw = *(const v2u*)(PLE + o2);
                        const f32x4 a = acc[ai][bj][m][n] * rstd; f32x4 o;
                        o[0] = b[0] + bflo(pw.x) * sigm(a[0]); o[1] = b[1] + bfhi(pw.x) * sigm(a[1]); o[2] = b[2] + bflo(pw.y) * sigm(a[2]); o[3] = b[3] + bfhi(pw.y) * sigm(a[3]);
                        *(f32x4*)(out + o2) = o; q += (o[0] * o[0] + o[1] * o[1]) + (o[2] * o[2] + o[3] * o[3]); }
                q += __shfl_xor(q, 16); q += __shfl_xor(q, 32);
                if (fq == 0) P[r * 4 + wc] = q;
                asm volatile("" ::: "memory"); }
        LDS_WAIT(); __builtin_amdgcn_s_barrier(); asm volatile("" ::: "memory");
        const int t = wid * 64 + lane;
        if (t < 256) { const f32x4 p = *(const PG8_LAS f32x4*)(P + t * 4); SS[(size_t)(u.pm * 256 + t) * 4 + u.pn] = (p[0] + p[1]) + (p[2] + p[3]); }
        LDS_WAIT(); __builtin_amdgcn_s_barrier(); asm volatile("" ::: "memory");
    }
};

template <int CTRL> __device__ __forceinline__ float dpp_ror(float v) { return __builtin_bit_cast(float, __builtin_amdgcn_update_dpp(0, __builtin_bit_cast(int, v), CTRL, 0xf, 0xf, false)); }
struct EpiUp {
    static constexpr bool PERM = true, AFTER_DRAIN = false;
    const float* SSin; const float* cw; const float* cbias; bf16* ACT; float* RAWB;
    __device__ __forceinline__ void operator()(const pg8::f32x4 (&acc)[2][2][4][2], const pg8::Unit& u, int wr, int wc, int fr, int fq) const {
        const int ch0 = u.pn * 128 + wc * 32 + 8 * fq;
        const bool l15 = fr == 15, l14 = fr >= 14;
#pragma unroll
        for (int ai = 0; ai < 2; ++ai) {
            const int rowb = u.pm * 256 + ai * 128 + wr * 64;
            const int rb = rowb >> 6;
            float rstd[4];
#pragma unroll
            for (int m = 0; m < 4; ++m) { const f32x4 s4 = *(const f32x4*)((const char*)SSin + (size_t)(unsigned)((rowb + m * 16 + fr) * 16)); rstd[m] = 1.0f / sqrtf(((s4[0] + s4[1]) + (s4[2] + s4[3])) * (1.0f / 1024.0f) + EPS); }
#pragma unroll
            for (int n = 0; n < 2; ++n) {
                float gg[4][4];
#pragma unroll
                for (int bj = 0; bj < 2; ++bj) {
                    const int cc = bj * FF + ch0 + 4 * n;
                    const unsigned co = (unsigned)cc * 4u;
                    const f32x4 w0 = *(const f32x4*)((const char*)cw + (size_t)co), w1 = *(const f32x4*)((const char*)cw + (size_t)(co + NUP * 4u)), w2 = *(const f32x4*)((const char*)cw + (size_t)(co + NUP * 8u)), bb = *(const f32x4*)((const char*)cbias + (size_t)co);
                    f32x4 s[4];
#pragma unroll
                    for (int m = 0; m < 4; ++m) s[m] = acc[ai][bj][m][n] * rstd[m];
                    { const unsigned ro = (unsigned)((rb * 4) * NUP + u.pn * 256 + bj * 128 + wc * 32 + 8 * fq + 4 * n) * 4u;
                      if (fr < 2) *(f32x4*)((char*)RAWB + (size_t)(ro + (unsigned)(fr * NUP * 4))) = s[0];
                      if (fr >= 14) *(f32x4*)((char*)RAWB + (size_t)(ro + (unsigned)((fr - 12) * NUP * 4))) = s[3]; }
#pragma unroll
                    for (int m = 0; m < 4; ++m)
#pragma unroll
                        for (int j = 0; j < 4; ++j) {
                            const float cur = s[m][j], prv = m > 0 ? s[m - 1][j] : 0.f;
                            const float p1 = dpp_ror<0x121>(l15 ? prv : cur), p2 = dpp_ror<0x122>(l14 ? prv : cur);
                            const float cvv = bb[j] + w0[j] * p2 + w1[j] * p1 + w2[j] * cur;
                            if (bj == 0) gg[m][j] = gelu_t(cvv); else gg[m][j] *= cvv;
                        }
                    asm volatile("" ::: "memory"); __builtin_amdgcn_sched_barrier(0);
                }
#pragma unroll
                for (int m = 0; m < 4; ++m) {
                    v2u w; w.x = pk2(gg[m][0], gg[m][1]); w.y = pk2(gg[m][2], gg[m][3]);
                    if (m > 0 || fr >= 2) *(v2u*)((char*)ACT + (size_t)(unsigned)(((rowb + m * 16 + fr) * FF + ch0 + 4 * n) * 2)) = w;
                }
                asm volatile("" ::: "memory"); __builtin_amdgcn_sched_barrier(0);
            }
        }
    }
};

__global__ void __launch_bounds__(NTHR, 2) fwd_mega(Args args) {
    extern __shared__ __attribute__((aligned(16))) unsigned char lds_raw[];
    cg::grid_group grid = cg::this_grid();
    LAS unsigned char* lds = (LAS unsigned char*)lds_raw;
const int wave0 = __builtin_amdgcn_readfirstlane(threadIdx.x >> 6);
#define FRESH_TID() int lane_; asm volatile("v_mbcnt_lo_u32_b32 %0, -1, 0\n\tv_mbcnt_hi_u32_b32 %0, -1, %0" : "=v"(lane_)); const int lane = lane_, wave = wave0, tid = wave0 * 64 + lane_; const int gw = vcu * NWAVES + wave, NGW = G * NWAVES; (void)lane; (void)gw; (void)NGW
    const int G = gridDim.x, bx = blockIdx.x;
    const int vcu = (G % 8 == 0) ? (bx % 8) * (G / 8) + bx / 8 : bx;
    unsigned char* ws = args.ws;
    const float* x = args.in[0];
    bf16* Win_t = (bf16*)(ws + WS_WIN); bf16* Wa_t = (bf16*)(ws + WS_WA); bf16* Wb_t = (bf16*)(ws + WS_WB); bf16* Wout_t = (bf16*)(ws + WS_WOUT);
    bf16* Wup_t = (bf16*)(ws + WS_WUP); bf16* Wdn_t = (bf16*)(ws + WS_WDN); bf16* Wple_t = (bf16*)(ws + WS_WPLE); bf16* Wpg_t = (bf16*)(ws + WS_WPG); bf16* Wsm = (bf16*)(ws + WS_WS);
    float* LF = (float*)(ws + WS_LF); float* CUM = (float*)(ws + WS_CUM);
    float* SS1 = (float*)(ws + WS_SS1); float* SS2 = (float*)(ws + WS_SS2); float* SS3 = (float*)(ws + WS_SS3);
    bf16* PB = (bf16*)(ws + WS_PB); bf16* XN = (bf16*)(ws + WS_XN);
    bf16* ZU = (bf16*)(ws + WS_U); bf16* ZV = (bf16*)(ws + WS_V); bf16* ZQ = (bf16*)(ws + WS_Q); bf16* ZK = (bf16*)(ws + WS_K); bf16* ZVA = (bf16*)(ws + WS_VA);
    bf16* GA = (bf16*)args.out; bf16* GB = GA + (size_t)M * 1024;
    float* TMP = (float*)(ws + WS_TMP); bf16* MRG = (bf16*)(ws + WS_MRG); float* X1 = (float*)(ws + WS_X1); bf16* ACT = (bf16*)(ws + WS_ACT); bf16* PLEB = (bf16*)(ws + WS_PLEB);
    float* RAWB = args.out;

    {
        FRESH_TID();
        LAS float* scr = (LAS float*)(lds + wave * 16384);
        constexpr int I_IN = 16 * (NIN / 32), I_SQ = 16 * 32, I_UP = 16 * (NUP / 32), I_DN = (FF / 64) * 32, I_PLE = (PLED / 64) * 32;
        constexpr int NITEMS = I_IN + 4 * I_SQ + I_UP + I_DN + I_PLE;
        for (int it = gw; it < NITEMS; it += NGW) {
            int r = it;
            if (r < I_IN) { const int nb = r % (NIN / 32), kb = r / (NIN / 32), n0 = nb * 32; transpose_item(args.in[3], NINF, n0 < 5120 ? n0 : n0 + 16, kb * 64, Win_t, 1024, n0, nullptr, scr, lane); continue; } r -= I_IN;
            if (r < 4 * I_SQ) { const int w = r / I_SQ, q = r % I_SQ, nb = q % 32, kb = q / 32;
                const float* src = w == 0 ? args.in[9] : w == 1 ? args.in[10] : w == 2 ? args.in[11] : args.in[19]; bf16* dst = w == 0 ? Wa_t : w == 1 ? Wb_t : w == 2 ? Wout_t : Wpg_t;
                transpose_item(src, 1024, nb * 32, kb * 64, dst, 1024, nb * 32, w == 3 ? args.in[17] : nullptr, scr, lane); continue; } r -= 4 * I_SQ;
            if (r < I_UP) { const int nb = r % (NUP / 32), kb = r / (NUP / 32), n0 = nb * 32, pn = n0 >> 8, wi = n0 & 255;
                transpose_item(args.in[13], NUP, (wi >> 7) * FF + pn * 128 + (wi & 127), kb * 64, Wup_t, 1024, n0, args.in[12], scr, lane); continue; } r -= I_UP;
            if (r < I_DN) { const int nb = r % 32, kb = r / 32; transpose_item(args.in[16], 1024, nb * 32, kb * 64, Wdn_t, FF, nb * 32, nullptr, scr, lane); continue; } r -= I_DN;
            { const int nb = r % 32, kb = r / 32; transpose_item(args.in[18], 1024, nb * 32, kb * 64, Wple_t, PLED, nb * 32, nullptr, scr, lane); }
        }
        for (int i = bx * NTHR + tid; i < 8 * 128 * 128; i += G * NTHR) { const int s = i & 127, t = (i >> 7) & 127; Wsm[i] = (bf16)f2bf((s >> 6) <= (t >> 6) ? args.in[7][i] : 0.f); }
        for (int i = bx * NTHR + tid; i < M * PLED / 4; i += G * NTHR) { const f32x4 v = ((const f32x4*)args.in[1])[i]; v2u w; w.x = pk2(v[0], v[1]); w.y = pk2(v[2], v[3]); ((v2u*)PB)[i] = w; }
        __syncthreads();
        LAS float* wf = (LAS float*)lds;
        for (int i = tid; i < 16 * 1024; i += NTHR) { const int hh = i & 15, k = i >> 4; wf[hh * 1024 + k] = args.in[3][(size_t)k * NINF + 5120 + hh]; }
        __syncthreads();
        const float* gmix = args.in[2];
        for (int m = gw; m < M; m += NGW) {
            const f32x4* xr = (const f32x4*)(x + (size_t)m * 1024) + lane;
            f32x4 v[4]; float s2 = 0.f;
#pragma unroll
            for (int j = 0; j < 4; ++j) { v[j] = xr[64 * j]; s2 += (v[j][0] * v[j][0] + v[j][1] * v[j][1]) + (v[j][2] * v[j][2] + v[j][3] * v[j][3]); }
            const float rstd = 1.0f / sqrtf(wave_sum(s2) * (1.0f / 1024.0f) + EPS);
            v2u* o8 = (v2u*)(XN + (size_t)m * 1024) + lane;
#pragma unroll
            for (int j = 0; j < 4; ++j) { const f32x4 g4 = ((const f32x4*)gmix)[lane + 64 * j]; v[j] = v[j] * rstd * g4; v2u w; w.x = pk2(v[j][0], v[j][1]); w.y = pk2(v[j][2], v[j][3]); o8[64 * j] = w; }
            float mine = 0.f;
#pragma unroll 4
            for (int hh = 0; hh < 16; ++hh) { float d = 0.f;
#pragma unroll
                for (int j = 0; j < 4; ++j) { const f32x4 w4 = *(const LAS f32x4*)(wf + hh * 1024 + 4 * lane + 256 * j); d += (v[j][0] * w4[0] + v[j][1] * w4[1]) + (v[j][2] * w4[2] + v[j][3] * w4[3]); }
                d = wave_sum(d); if (lane == hh) mine = d; }
            if (lane < 16) { const float z = mine + args.in[4][lane]; const float ls = fminf(z, 0.f) - log1pf(expf(-fabsf(z)));
                LF[((size_t)(m / SEQ) * 16 + lane) * SEQ + (m % SEQ)] = ls * LOG2E; }
        }
    }
    grid.sync();

    {
        FRESH_TID();
        if (bx < NBATCH * NHEAD) {
            LAS float* wsum = (LAS float*)lds;
            f32x4 v = *(const f32x4*)(LF + (size_t)bx * SEQ + 4 * tid);
            v[1] += v[0]; v[2] += v[1]; v[3] += v[2];
            const float tot = v[3]; float inc = tot;
#pragma unroll
            for (int o = 1; o < 64; o <<= 1) { const float n = __shfl_up(inc, o); if (lane >= o) inc += n; }
            if (lane == 63) wsum[wave] = inc;
            __syncthreads();
            float pre = 0.f;
            for (int w = 0; w < wave; ++w) pre += wsum[w];
            const float ex = inc - tot + pre;
            v = v + ex;
            *(f32x4*)(CUM + (size_t)bx * SEQ + 4 * tid) = v;
            __syncthreads();
        }
        pg8::Gemm g{XN, Win_t, M, NIN, 1024, XN, Win_t}; pg8::StaticOrder S; S.init(M, NIN, G, bx);
        EpiIn E{ZU, GA};
#ifndef SKIP_IN
        pg8::gemm_phase<EpiIn, pg8::StaticOrder, true, true>(lds, g, S, E, wave0);
#endif
    }
    grid.sync();

    {
        FRESH_TID();
        const attn_body::AttnTensors AT{(const attn_body::bf16*)ZQ, (const attn_body::bf16*)ZK, (const attn_body::bf16*)ZVA, (attn_body::bf16*)ZQ, CUM};
        const attn_body::StaticOrder S(G, bx);
#ifndef SKIP_ATTN
        attn_body::attn_phase<attn_body::StaticOrder>((char*)lds_raw, AT, S, wave0);
#endif
        __syncthreads();
        const int bn = vcu >> 1, g0 = (vcu & 1) * 4, R0 = bn * 128;
        LAS float* stat = (LAS float*)lds;
        LAS bf16* vT = (LAS bf16*)(lds + 1024);
        const int fr = lane & 15, fq = lane >> 4;
        for (int r = 0; r < 16; ++r) {
            const v4u* vp = (const v4u*)(ZV + (size_t)(R0 + 16 * wave + r) * 1024) + lane;
            const v4u a = vp[0], b = vp[64]; float s = 0.f, q = 0.f;
#pragma unroll
            for (int e = 0; e < 4; ++e) { const float x0 = bflo(a[e]), x1 = bfhi(a[e]), x2 = bflo(b[e]), x3 = bfhi(b[e]); s += (x0 + x1) + (x2 + x3); q += (x0 * x0 + x1 * x1) + (x2 * x2 + x3 * x3); }
            s = wave_sum(s); q = wave_sum(q);
            const float mean = s * (1.0f / 1024.0f), var = fmaxf(q * (1.0f / 1024.0f) - mean * mean, 0.f);
            if (lane == 0) { stat[2 * (16 * wave + r)] = mean; stat[2 * (16 * wave + r) + 1] = 1.0f / sqrtf(var + EPS); }
        }
        __syncthreads();
        for (int gi = 0; gi < 4; ++gi) {
            const int g = g0 + gi;
            { const int cc = tid & 15;
              f32x4 lg0 = *(const f32x4*)(args.in[5] + 128 * g + 8 * cc), lg1 = *(const f32x4*)(args.in[5] + 128 * g + 8 * cc + 4);
              f32x4 lb0 = *(const f32x4*)(args.in[6] + 128 * g + 8 * cc), lb1 = *(const f32x4*)(args.in[6] + 128 * g + 8 * cc + 4);
#pragma unroll
              for (int i = 0; i < 4; ++i) { const int s = (tid >> 4) + 32 * i; const v4u raw = *(const v4u*)(ZV + (size_t)(R0 + s) * 1024 + 128 * g + 8 * cc);
                  const float mean = stat[2 * s], rstd = stat[2 * s + 1];
#pragma unroll
                  for (int e = 0; e < 4; ++e) { const float y0 = (bflo(raw[e]) - mean) * rstd * (e < 2 ? lg0[2 * e] : lg1[2 * e - 4]) + (e < 2 ? lb0[2 * e] : lb1[2 * e - 4]);
                      const float y1 = (bfhi(raw[e]) - mean) * rstd * (e < 2 ? lg0[2 * e + 1] : lg1[2 * e - 3]) + (e < 2 ? lb0[2 * e + 1] : lb1[2 * e - 3]);
                      vT[(8 * cc + 2 * e) * 136 + s] = (bf16)f2bf(y0); vT[(8 * cc + 2 * e + 1) * 136 + s] = (bf16)f2bf(y1); } } }
            __syncthreads();
            f32x4 acc[8];
#pragma unroll
            for (int nb = 0; nb < 8; ++nb) acc[nb] = (f32x4){0.f, 0.f, 0.f, 0.f};
            const int kmax = wave < 4 ? 2 : 4;
            for (int k = 0; k < kmax; ++k) {
                const bf16x8 afr = *(const bf16x8*)(Wsm + (size_t)(g * 128 + 16 * wave + fr) * 128 + 32 * k + 8 * fq);
#pragma unroll
                for (int nb = 0; nb < 8; ++nb) { const bf16x8 bfr = *(const LAS bf16x8*)(vT + (16 * nb + fr) * 136 + 32 * k + 8 * fq);
                    acc[nb] = __builtin_amdgcn_mfma_f32_16x16x32_bf16(bfr, afr, acc[nb], 0, 0, 0); }
            }
            const int t = 16 * wave + fr; const float bias = args.in[8][g * 128 + t];
#pragma unroll
            for (int nb = 0; nb < 8; ++nb) { v2u* up = (v2u*)(ZU + (size_t)(R0 + t) * 1024 + 128 * g + 16 * nb + 4 * fq); const v2u uw = *up; v2u w;
                w.x = pk2(bflo(uw.x) * (acc[nb][0] + bias), bfhi(uw.x) * (acc[nb][1] + bias)); w.y = pk2(bflo(uw.y) * (acc[nb][2] + bias), bfhi(uw.y) * (acc[nb][3] + bias)); *up = w; }
            __syncthreads();
        }
    }
    grid.sync();

    {
        pg8::Gemm g{ZU, Wa_t, M, 1024, 1024, ZQ, Wb_t}; SegOrder S; S.S.init(M, 1024, G, bx); S.nseg = 2;
        EpiMerge E{GA, GB, TMP, MRG};
#ifndef SKIP_MRG
        pg8::gemm_phase<EpiMerge, SegOrder, true, true>(lds, g, S, E, wave0);
#endif
    }
    grid.sync();

    {
        pg8::Gemm g{MRG, Wout_t, M, 1024, 1024, MRG, Wout_t}; pg8::StaticOrder S; S.init(M, 1024, G, bx);
        EpiResid E{x, X1, XN, SS1};
        pg8::gemm_phase<EpiResid, pg8::StaticOrder, false, true>(lds, g, S, E, wave0);
    }
    grid.sync();

    {
        pg8::Gemm g{XN, Wup_t, M, NUP, 1024, XN, Wup_t}; pg8::StaticOrder S; S.init(M, NUP, G, bx);
        EpiUp E{SS1, args.in[14], args.in[15], ACT, RAWB};
#ifndef SKIP_UP
        pg8::gemm_phase<EpiUp, pg8::StaticOrder, true, true>(lds, g, S, E, wave0);
#endif
    }
    grid.sync();

    {
        FRESH_TID();
        pg8::StaticOrder S; S.init(M, 1024, G, bx); pg8::Unit u0;
        if (S.next(0, u0)) {
            const float* cw = args.in[14]; const float* cbias = args.in[15];
            for (int e = tid; e < 4 * FF; e += NTHR) {
                const int i = e / FF, ch = e % FF, rb = 4 * u0.pm + i; const bool first = (rb & 31) == 0;
                float cvv[2][2];
#pragma unroll
                for (int bj = 0; bj < 2; ++bj) {
                    const int colT = (ch >> 7) * 256 + bj * 128 + (ch & 127), cc = bj * FF + ch;
                    const float c0 = RAWB[((size_t)rb * 4 + 0) * NUP + colT], c1 = RAWB[((size_t)rb * 4 + 1) * NUP + colT];
                    const float p62 = first ? 0.f : RAWB[((size_t)(rb - 1) * 4 + 2) * NUP + colT], p63 = first ? 0.f : RAWB[((size_t)(rb - 1) * 4 + 3) * NUP + colT];
                    const float w0 = cw[cc], w1 = cw[NUP + cc], w2 = cw[2 * NUP + cc], bb = cbias[cc];
                    cvv[bj][0] = bb + w0 * p62 + w1 * p63 + w2 * c0; cvv[bj][1] = bb + w0 * p63 + w1 * c0 + w2 * c1;
                }
                ACT[(size_t)(64 * rb) * FF + ch] = (bf16)f2bf(gelu_t(cvv[0][0]) * cvv[1][0]);
                ACT[(size_t)(64 * rb + 1) * FF + ch] = (bf16)f2bf(gelu_t(cvv[0][1]) * cvv[1][1]);
            }
        }
        VM_WAIT(); __syncthreads();
        pg8::Gemm g{ACT, Wdn_t, M, 1024, FF, ACT, Wdn_t};
        EpiResid E{X1, X1, XN, SS2};
        pg8::gemm_phase<EpiResid, pg8::StaticOrder, false, true>(lds, g, S, E, wave0);
    }
    grid.sync();

    {
        pg8::StaticOrder S; S.init(M, 1024, G, bx);
        { pg8::Gemm g{PB, Wple_t, M, 1024, PLED, PB, Wple_t}; EpiPlain E{PLEB}; pg8::gemm_phase<EpiPlain, pg8::StaticOrder, false, true>(lds, g, S, E, wave0); }
        VM_WAIT(); __syncthreads();
        { pg8::Gemm g{XN, Wpg_t, M, 1024, 1024, XN, Wpg_t}; EpiPleGate E{X1, PLEB, SS2, args.out, SS3}; pg8::gemm_phase<EpiPleGate, pg8::StaticOrder, false, true>(lds, g, S, E, wave0); }
    }
    grid.sync();

    {
        FRESH_TID();
        const float* gf = args.in[20];
        for (int m = gw; m < M; m += NGW) {
            const f32x4 s4 = *(const f32x4*)(SS3 + (size_t)m * 4); const float rstd = 1.0f / sqrtf(((s4[0] + s4[1]) + (s4[2] + s4[3])) * (1.0f / 1024.0f) + EPS);
            f32x4* xr = (f32x4*)(args.out + (size_t)m * 1024) + lane;
#pragma unroll
            for (int j = 0; j < 4; ++j) { const f32x4 g4 = ((const f32x4*)gf)[lane + 64 * j]; xr[64 * j] = xr[64 * j] * rstd * g4; }
        }
    }
}

extern "C" void kernel_launch(void* const* d_in, const int* in_sizes, int n_in, void* d_out, int out_size, void* d_ws, size_t ws_size, hipStream_t stream) {
    static int grid = 0;
    if (grid == 0) {
        if (n_in != 21 || out_size != M * 1024 || ws_size < WS_END) { fprintf(stderr, "kernel_launch: unexpected shapes (n_in %d out %d ws %zu)\n", n_in, out_size, ws_size); grid = -1; return; }
        int dev = 0, cus = 0, per_cu = 0;
        hipGetDevice(&dev); hipDeviceGetAttribute(&cus, hipDeviceAttributeMultiprocessorCount, dev);
        if (hipFuncSetAttribute((const void*)fwd_mega, hipFuncAttributeMaxDynamicSharedMemorySize, LDS_BYTES) != hipSuccess) { fprintf(stderr, "kernel_launch: hipFuncSetAttribute failed\n"); grid = -1; return; }
        if (hipOccupancyMaxActiveBlocksPerMultiprocessor(&per_cu, (const void*)fwd_mega, NTHR, LDS_BYTES) != hipSuccess || per_cu < 1) { fprintf(stderr, "kernel_launch: occupancy query gave %d\n", per_cu); per_cu = 1; }
        (void)hipGetLastError();
        grid = cus;
        fprintf(stderr, "kernel_launch: grid %d (cus %d, per_cu %d)\n", grid, cus, per_cu);
    }
    if (grid < 0) return;
    Args a{};
    for (int i = 0; i < 21; ++i) a.in[i] = (const float*)d_in[i];
    a.out = (float*)d_out; a.ws = (unsigned char*)d_ws;
    void* kargs[] = {&a};
    hipError_t e = hipLaunchCooperativeKernel((const void*)fwd_mega, dim3(grid), dim3(NTHR), kargs, LDS_BYTES, stream);
    if (e != hipSuccess) fprintf(stderr, "kernel_launch: cooperative launch failed: %s (grid %d)\n", hipGetErrorString(e), grid);
}
```

```cpp
#include <hip/hip_runtime.h>
#include <hip/hip_cooperative_groups.h>
#include <hip/hip_bf16.h>
#include <cstdio>
#include <cstdint>
#include <cmath>
namespace pg8 {
#define PG8_LAS __attribute__((address_space(3)))
typedef unsigned short bf16_t;
typedef short bf16x8 __attribute__((ext_vector_type(8)));
typedef float f32x4 __attribute__((ext_vector_type(4)));
typedef unsigned u32x4 __attribute__((ext_vector_type(4)));
constexpr int BM = 256, BK = 64, HALF = 128, HTB = HALF * BK * 2  , STAGE_BYTES = 8 * HTB, NXCD = 8, WGM = 8;

__host__ __device__ __forceinline__ int lds_byte(int r, int c) { const int st = (r >> 4) * 2 + (c >> 5), rr = r & 15, cc = c & 31, ob = rr * 64 + cc * 2; return st * 1024 + (ob ^ (((ob >> 9) & 1) << 5)); }
__host__ __device__ __forceinline__ void stage_rc(int b, int& R, int& C) { const int st = b / 1024, sb = b % 1024, swz = sb ^ (((sb >> 9) & 1) << 5); R = (st >> 1) * 16 + swz / 64; C = (st & 1) * 32 + (swz % 64) / 2; }
__host__ __device__ __forceinline__ int perm32(int rho) { const int n = rho >> 4, i = rho & 15; return 8 * (i >> 2) + 4 * n + (i & 3); }

struct Unit { int pm, pn, seg; };
struct Gemm { const bf16_t* A; const bf16_t* Bt; int M, N, K; const bf16_t* A1; const bf16_t* Bt1; };

struct StaticOrder {
    int nM, nN, nwg, G, c;
    __host__ __device__ void init(int M, int N, int G_, int c_) { nM = M / BM; nN = N / BM; nwg = nM * nN; G = G_; c = c_; }
    __host__ __device__ bool next(int i, Unit& u) const {
        const long L = (long)i * G + c; if (L >= nwg) return false;
        int wgid = (int)L; { const int q = nwg / NXCD, r = nwg % NXCD, xcd = wgid % NXCD, off = wgid / NXCD; wgid = (xcd < r ? xcd * (q + 1) : r * (q + 1) + (xcd - r) * q) + off; }
        const int nig = WGM * nN, gid = wgid / nig, fm = gid * WGM, gsz = (nM - fm) < WGM ? (nM - fm) : WGM;
        u.pm = fm + ((wgid % nig) % gsz); u.pn = (wgid % nig) / gsz; u.seg = 0; return true;
    }
    __device__ __forceinline__ void a_ready(const Unit&) const {}
    __device__ __forceinline__ void done(const Unit&) const {}
};

__device__ __forceinline__ unsigned cvt_pk_bf16(float lo, float hi) { unsigned r; asm volatile("v_cvt_pk_bf16_f32 %0, %1, %2" : "=v"(r) : "v"(lo), "v"(hi)); return r; }
typedef float f32x2 __attribute__((ext_vector_type(2)));
__device__ __forceinline__ f32x2 gelu_pk(f32x2 v) {
    const f32x2 av = __builtin_elementwise_abs(v), d = av * 0.2316418882f + 1.0f;
    f32x2 t; t.x = __builtin_amdgcn_rcpf(d.x); t.y = __builtin_amdgcn_rcpf(d.y);
    f32x2 q = t * 0.5307027145f + (-0.7265760135f); q = q * t + 0.7107068705f; q = q * t + (-0.142248368f); q = q * t + 0.127414796f; q = q * t;
    const f32x2 s = (v * v) * (-0.72134752044f);
    f32x2 e; e.x = __builtin_amdgcn_exp2f(s.x); e.y = __builtin_amdgcn_exp2f(s.y);
    const f32x2 m = v * (q * e), r = v - m;
    f32x2 o; o.x = v.x < 0.f ? m.x : r.x; o.y = v.y < 0.f ? m.y : r.y; return o;
}

template <class Epi, class Sched, bool ALIGN_EPI = false, bool SP2 = false>
__device__ __forceinline__ void gemm_phase(PG8_LAS unsigned char* lds, const Gemm g, const Sched& S, const Epi& E, const int wave0) {
    int lane_; asm volatile("v_mbcnt_lo_u32_b32 %0, -1, 0\n\tv_mbcnt_hi_u32_b32 %0, -1, %0" : "=v"(lane_)); const int tid = wave0 * 64 + lane_, wid = wave0, lane = tid & 63, wr = wid >> 2, wc = wid & 3, fr = lane & 15, fq = lane >> 4;
    const int K = g.K, nt = K / BK;
    unsigned voffA[2], voffB[2];
#pragma unroll
    for (int i = 0; i < 2; ++i) { int R, C; stage_rc(tid * 16 + i * 8192, R, C); const int Rb = Epi::PERM ? ((R & ~31) + perm32(R & 31)) : R;
        voffA[i] = (unsigned)(R * K + C) * 2u; voffB[i] = (unsigned)(Rb * K + C) * 2u; }
    const size_t kstep = (size_t)(BK * 2);
    const size_t hstep = (size_t)HALF * K * 2;
    const size_t tstep = 2 * hstep;
    const unsigned ldsw = (unsigned)wid * 1024u;
    const int aoff = lds_byte(wr * 64 + fr, fq * 8), boff = lds_byte(wc * 32 + fr, fq * 8);
#define PG8_SA(b, h) (((b) * 2 + (h)) * HTB)
#define PG8_SB(b, h) ((4 + (b) * 2 + (h)) * HTB)
#define PG8_STAGE(bufoff, gbase, voff) do { _Pragma("unroll") for (int _i = 0; _i < 2; ++_i) \
        __builtin_amdgcn_global_load_lds((const unsigned*)((const char*)(gbase) + (voff)[_i]), (PG8_LAS unsigned*)(lds + (bufoff) + ldsw + _i * 8192), 16, 0, 0); } while (0)
#define PG8_LDA(dst, b, h) do { _Pragma("unroll") for (int m = 0; m < 4; ++m) _Pragma("unroll") for (int k = 0; k < 2; ++k) dst[m][k] = *(const PG8_LAS bf16x8*)(lds + PG8_SA(b, h) + aoff + m * 2048 + k * 1024); } while (0)
#define PG8_LDB(dst, b, h) do { _Pragma("unroll") for (int n = 0; n < 2; ++n) _Pragma("unroll") for (int k = 0; k < 2; ++k) dst[n][k] = *(const PG8_LAS bf16x8*)(lds + PG8_SB(b, h) + boff + n * 2048 + k * 1024); } while (0)
#define PG8_MMA(ai, bj, At, Bt) do { __builtin_amdgcn_s_setprio(1); _Pragma("unroll") for (int m = 0; m < 4; ++m) _Pragma("unroll") for (int n = 0; n < 2; ++n) _Pragma("unroll") for (int k = 0; k < 2; ++k) \
        acc[ai][bj][m][n] = __builtin_amdgcn_mfma_f32_16x16x32_bf16(Bt[n][k], At[m][k], acc[ai][bj][m][n], 0, 0, 0); __builtin_amdgcn_s_setprio(0); } while (0)
#define PG8_WAIT_V(n) asm volatile("s_waitcnt vmcnt(" #n ")" ::: "memory")
#define PG8_WAIT_L(n) asm volatile("s_waitcnt lgkmcnt(" #n ")" ::: "memory")
#define PG8_BAR __builtin_amdgcn_s_barrier()
#define PG8_SCHED __builtin_amdgcn_sched_barrier(0)
    Unit cur, nxt; int ui = 0;
    if (!S.next(0, cur)) return;
    f32x4 acc[2][2][4][2];
#pragma unroll
    for (int a = 0; a < 2; ++a)
#pragma unroll
        for (int b = 0; b < 2; ++b)
#pragma unroll
            for (int m = 0; m < 4; ++m)
#pragma unroll
                for (int n = 0; n < 2; ++n) acc[a][b][m][n] = (f32x4){0.f, 0.f, 0.f, 0.f};
    bf16x8 At[4][2], B0[2][2], B1[2][2];
    const char* cA = (const char*)(cur.seg ? g.A1 : g.A) + (size_t)cur.pm * tstep; const char* cB = (const char*)(cur.seg ? g.Bt1 : g.Bt) + (size_t)cur.pn * tstep;
    S.a_ready(cur);
    if constexpr (SP2) {
        PG8_STAGE(PG8_SB(0, 0), cB, voffB); PG8_STAGE(PG8_SB(0, 1), cB + hstep, voffB); PG8_STAGE(PG8_SA(0, 0), cA, voffA); PG8_STAGE(PG8_SA(0, 1), cA + hstep, voffA);
        if (wr == 1) PG8_BAR;
        PG8_WAIT_V(2); PG8_BAR;
        PG8_STAGE(PG8_SB(1, 0), cB + kstep, voffB); PG8_STAGE(PG8_SA(1, 0), cA + kstep, voffA); PG8_STAGE(PG8_SB(1, 1), cB + hstep + kstep, voffB);
        PG8_WAIT_V(6); PG8_BAR;
    } else {
        PG8_STAGE(PG8_SB(0, 0), cB, voffB); PG8_STAGE(PG8_SA(0, 0), cA, voffA); PG8_STAGE(PG8_SB(0, 1), cB + hstep, voffB); PG8_STAGE(PG8_SA(0, 1), cA + hstep, voffA);
        if (wr == 1) PG8_BAR;
        PG8_WAIT_V(4); PG8_BAR;
        PG8_STAGE(PG8_SB(1, 0), cB + kstep, voffB); PG8_STAGE(PG8_SA(1, 0), cA + kstep, voffA); PG8_STAGE(PG8_SB(1, 1), cB + hstep + kstep, voffB);
        PG8_WAIT_V(6); PG8_BAR;
    }
    for (;;) {
        const bool has_next = S.next(ui + 1, nxt);
        const char* nA = has_next ? (const char*)(nxt.seg ? g.A1 : g.A) + (size_t)nxt.pm * tstep : cA; const char* nB = has_next ? (const char*)(nxt.seg ? g.Bt1 : g.Bt) + (size_t)nxt.pn * tstep : cB;
        for (int t = 0; t < nt; t += 2) {
            const bool last = (t == nt - 2);
            const char* a1 = cA + (size_t)(t + 1) * kstep;
            const char* a2 = last ? nA : cA + (size_t)(t + 2) * kstep; const char* b2 = last ? nB : cB + (size_t)(t + 2) * kstep;
            const char* a3 = a2 + kstep; const char* b3 = b2 + kstep;
            if (last && has_next) S.a_ready(nxt);
            if constexpr (SP2) {
            PG8_LDB(B0, 0, 0); PG8_LDB(B1, 0, 1); PG8_SCHED; PG8_LDA(At, 0, 0); PG8_STAGE(PG8_SA(1, 1), a1 + hstep, voffA);
            PG8_WAIT_V(8); PG8_WAIT_L(0); PG8_BAR; PG8_MMA(0, 0, At, B0); PG8_MMA(0, 1, At, B1); PG8_BAR; PG8_SCHED;
            PG8_LDA(At, 0, 1); PG8_STAGE(PG8_SB(0, 0), b2, voffB); PG8_STAGE(PG8_SB(0, 1), b2 + hstep, voffB); PG8_STAGE(PG8_SA(0, 0), a2, voffA);
            PG8_WAIT_V(8); PG8_WAIT_L(0); PG8_BAR; PG8_MMA(1, 0, At, B0); PG8_MMA(1, 1, At, B1); PG8_BAR; PG8_SCHED;
            PG8_LDB(B0, 1, 0); PG8_LDB(B1, 1, 1); PG8_SCHED; PG8_LDA(At, 1, 0); PG8_STAGE(PG8_SA(0, 1), a2 + hstep, voffA);
            PG8_WAIT_V(8); PG8_WAIT_L(0); PG8_BAR; PG8_MMA(0, 0, At, B0); PG8_MMA(0, 1, At, B1); PG8_BAR; PG8_SCHED;
            PG8_LDA(At, 1, 1); PG8_STAGE(PG8_SB(1, 0), b3, voffB); PG8_STAGE(PG8_SB(1, 1), b3 + hstep, voffB); PG8_STAGE(PG8_SA(1, 0), a3, voffA);
            PG8_WAIT_V(8); PG8_WAIT_L(0); PG8_BAR; PG8_MMA(1, 0, At, B0); PG8_MMA(1, 1, At, B1); PG8_BAR; PG8_SCHED;
            } else {
            PG8_LDB(B0, 0, 0); PG8_SCHED; PG8_LDA(At, 0, 0); PG8_STAGE(PG8_SA(1, 1), a1 + hstep, voffA);
            PG8_WAIT_L(8); PG8_BAR; PG8_WAIT_L(0); PG8_MMA(0, 0, At, B0); PG8_BAR; PG8_SCHED;
            PG8_LDB(B1, 0, 1); PG8_STAGE(PG8_SB(0, 0), b2, voffB);
            PG8_BAR; PG8_WAIT_L(0); PG8_MMA(0, 1, At, B1); PG8_BAR;
            PG8_LDA(At, 0, 1); PG8_STAGE(PG8_SA(0, 0), a2, voffA);
            PG8_BAR; PG8_WAIT_L(0); PG8_MMA(1, 0, At, B0); PG8_BAR; PG8_SCHED;
            PG8_STAGE(PG8_SB(0, 1), b2 + hstep, voffB);
            PG8_WAIT_V(6); PG8_BAR; PG8_MMA(1, 1, At, B1); PG8_BAR;
            PG8_LDB(B0, 1, 0); PG8_SCHED; PG8_LDA(At, 1, 0); PG8_STAGE(PG8_SA(0, 1), a2 + hstep, voffA);
            PG8_WAIT_L(8); PG8_BAR; PG8_WAIT_L(0); PG8_MMA(0, 0, At, B0); PG8_BAR; PG8_SCHED;
            PG8_LDB(B1, 1, 1); PG8_STAGE(PG8_SB(1, 0), b3, voffB);
            PG8_BAR; PG8_WAIT_L(0); PG8_MMA(0, 1, At, B1); PG8_BAR;
            PG8_LDA(At, 1, 1); PG8_STAGE(PG8_SA(1, 0), a3, voffA);
            PG8_BAR; PG8_WAIT_L(0); PG8_MMA(1, 0, At, B0); PG8_BAR; PG8_SCHED;
            PG8_STAGE(PG8_SB(1, 1), b3 + hstep, voffB);
            PG8_WAIT_V(6); PG8_BAR; PG8_MMA(1, 1, At, B1); PG8_BAR;
            }
        }
        if constexpr (ALIGN_EPI) { if (wr == 0) PG8_BAR; }
        if constexpr (!Epi::AFTER_DRAIN) { E(acc, cur, wr, wc, fr, fq); S.done(cur); }
        if (!has_next) break;
#pragma unroll
        for (int a = 0; a < 2; ++a)
#pragma unroll
            for (int b = 0; b < 2; ++b)
#pragma unroll
                for (int m = 0; m < 4; ++m)
#pragma unroll
                    for (int n = 0; n < 2; ++n) acc[a][b][m][n] = (f32x4){0.f, 0.f, 0.f, 0.f};
        cur = nxt; cA = nA; cB = nB; ++ui;
        if constexpr (ALIGN_EPI) { if (wr == 1) PG8_BAR; }
    }
    PG8_WAIT_V(0);
    if constexpr (!ALIGN_EPI) { if (wr == 0) PG8_BAR; }
    PG8_BAR;
    if constexpr (Epi::AFTER_DRAIN) { E.fused(acc, cur, wr, wc, fr, fq, lds, wid, lane); S.done(cur); }
#undef PG8_SA
#undef PG8_SB
#undef PG8_STAGE
#undef PG8_LDA
#undef PG8_LDB
#undef PG8_MMA
#undef PG8_WAIT_V
#undef PG8_WAIT_L
#undef PG8_BAR
#undef PG8_SCHED
}
}
namespace attn_body {
using bf16=__hip_bfloat16;
using bf16x8=__attribute__((ext_vector_type(8)))short;
using s16x4=__attribute__((ext_vector_type(4)))short;
using f32x16=__attribute__((ext_vector_type(16)))float;
using u32x4=__attribute__((ext_vector_type(4)))unsigned;
constexpr int BATCH=8,NHEAD=16,SEQ=2048,D=64,DM=NHEAD*D;
constexpr int NW=8,QBLK=32,QB=QBLK*NW,KVBLK=64,NQB=SEQ/QB;
constexpr int ATTN_PITCH=DM, ATTN_UNIT_ROWS=QB;
__device__ __forceinline__ int crow(int r,int hi){return (r&3)+8*(r>>2)+4*hi;}
#define SBAR() __builtin_amdgcn_sched_barrier(0)
__device__ __forceinline__ void cmask(f32x16&p0,f32x16&p1,int jb,int qrel,int hi){
  const float NEG=-INFINITY; int kb=64*jb+4*hi;
  #pragma unroll
  for(int r=0;r<16;++r){int kv=kb+(r&3)+8*(r>>2); if(kv>qrel)p0[r]=NEG; if(kv+32>qrel)p1[r]=NEG;}
}

constexpr int NSLOT=3, SLOTB=8192;
constexpr int LDS_K=0, LDS_V=NSLOT*SLOTB, LDS_WS=2*NSLOT*SLOTB, LDS_OST=LDS_WS+NW*64*4, LDS_CUM=LDS_OST+NW*4096, LDS_BYTES=LDS_CUM+SEQ*4;
constexpr float C2=0.125f*1.4426950408889634f;
__device__ __forceinline__ void glds16(const void*gsrc,unsigned lds_dst){unsigned keep;
  asm volatile("s_mov_b32 %0, m0\n\ts_mov_b32 m0, %2\n\ts_nop 0\n\tglobal_load_lds_dwordx4 %1, off\n\ts_mov_b32 m0, %0":"=&s"(keep):"v"(gsrc),"s"(lds_dst):"memory");}
__device__ __forceinline__ float max3f(float a,float b,float c){float r;asm("v_max3_f32 %0, %1, %2, %3":"=v"(r):"v"(a),"v"(b),"v"(c));return r;}
__device__ __forceinline__ float max2f(float a,float b){float r;asm("v_max_f32_e32 %0, %1, %2":"=v"(r):"v"(a),"v"(b));return r;}
__device__ __forceinline__ float fadd_s(float a,float b){float r;asm("v_add_f32_e32 %0, %1, %2":"=v"(r):"v"(a),"v"(b));return r;}
__device__ __forceinline__ float fsub_s(float a,float b){float r;asm("v_sub_f32_e32 %0, %1, %2":"=v"(r):"v"(a),"v"(b));return r;}
typedef float f32x2_t __attribute__((ext_vector_type(2))); typedef __bf16 bf16x2_t __attribute__((ext_vector_type(2)));
__device__ __forceinline__ unsigned cvtpk_s(float lo,float hi){f32x2_t v={lo,hi};bf16x2_t b=__builtin_convertvector(v,bf16x2_t);return __builtin_bit_cast(unsigned,b);}
#define WAIT_BAR(N) asm volatile("s_waitcnt vmcnt(" #N ") lgkmcnt(0)\n\ts_barrier":::"memory")

__device__ __forceinline__ void qkt(f32x16&p0,f32x16&p1,const char*Kslot,const bf16x8*qr,int r32,int hi){
  const char*kb=Kslot+hi*1024+r32*16;
  #pragma unroll
  for(int d0=0;d0<4;++d0){
    const bf16x8 b0=*reinterpret_cast<const bf16x8*>(kb+d0*2048);
    const bf16x8 b1=*reinterpret_cast<const bf16x8*>(kb+d0*2048+512);
    {p0=__builtin_amdgcn_mfma_f32_32x32x16_bf16(b0,qr[d0],p0,0,0,0);p1=__builtin_amdgcn_mfma_f32_32x32x16_bf16(b1,qr[d0],p1,0,0,0);}}
}
typedef __attribute__((address_space(3))) const char* lds_cptr;
typedef short v4i16_t __attribute__((ext_vector_type(4)));
__device__ __forceinline__ void kload8(bf16x8*kf,lds_cptr kp){
  kf[0]=*(const __attribute__((address_space(3))) bf16x8*)(kp);      kf[1]=*(const __attribute__((address_space(3))) bf16x8*)(kp+512);
  kf[2]=*(const __attribute__((address_space(3))) bf16x8*)(kp+2048); kf[3]=*(const __attribute__((address_space(3))) bf16x8*)(kp+2560);
  kf[4]=*(const __attribute__((address_space(3))) bf16x8*)(kp+4096); kf[5]=*(const __attribute__((address_space(3))) bf16x8*)(kp+4608);
  kf[6]=*(const __attribute__((address_space(3))) bf16x8*)(kp+6144); kf[7]=*(const __attribute__((address_space(3))) bf16x8*)(kp+6656);
}
__device__ __forceinline__ void kload2(bf16x8*kf,lds_cptr kp,int j){ kf[2*j]=*(const __attribute__((address_space(3))) bf16x8*)(kp+j*2048); kf[2*j+1]=*(const __attribute__((address_space(3))) bf16x8*)(kp+j*2048+512); }
__device__ __forceinline__ s16x4 vtr(lds_cptr p){ return __builtin_bit_cast(s16x4,__builtin_amdgcn_ds_read_tr16_b64_v4i16((__attribute__((address_space(3))) v4i16_t*)p)); }
__device__ __forceinline__ float rowmax(const f32x16&p0,const f32x16&p1){
  float a=max3f(p0[0],p0[1],p1[0]),b=max3f(p0[2],p0[3],p1[1]);a=max3f(a,p1[2],p1[3]);
  #pragma unroll
  for(int r=4;r<16;r+=4){a=max3f(a,p0[r],p0[r+1]);b=max3f(b,p0[r+2],p0[r+3]);a=max3f(a,p1[r],p1[r+1]);b=max3f(b,p1[r+2],p1[r+3]);}
  const float m=max2f(a,b);
  auto rr=__builtin_amdgcn_permlane32_swap(__float_as_uint(m),__float_as_uint(m),false,false);
  return max2f(__uint_as_float(rr[0]),__uint_as_float(rr[1]));
}
__device__ __forceinline__ void pv(f32x16*o,int vb,bf16x8 pa0,bf16x8 pa1,bf16x8 pa2,bf16x8 pa3){
  #pragma unroll
  for(int d0=0;d0<2;++d0){s16x4 lo[4],hi[4];
    #pragma unroll
    for(int ks=0;ks<4;++ks){
      asm volatile("ds_read_b64_tr_b16 %0,%1 offset:%c2":"=&v"(lo[ks]):"v"(vb),"i"(d0*4096+ks*1024):"memory");
      asm volatile("ds_read_b64_tr_b16 %0,%1 offset:%c2":"=&v"(hi[ks]):"v"(vb),"i"(d0*4096+ks*1024+512):"memory");}
    asm volatile("s_waitcnt lgkmcnt(0)":::"memory");SBAR();
    #define PK(k) (bf16x8){lo[k][0],lo[k][1],lo[k][2],lo[k][3],hi[k][0],hi[k][1],hi[k][2],hi[k][3]}
    o[d0]=__builtin_amdgcn_mfma_f32_32x32x16_bf16(pa0,PK(0),o[d0],0,0,0);
    o[d0]=__builtin_amdgcn_mfma_f32_32x32x16_bf16(pa1,PK(1),o[d0],0,0,0);
    o[d0]=__builtin_amdgcn_mfma_f32_32x32x16_bf16(pa2,PK(2),o[d0],0,0,0);
    o[d0]=__builtin_amdgcn_mfma_f32_32x32x16_bf16(pa3,PK(3),o[d0],0,0,0);
    #undef PK
  }
}

#ifndef ATTN_STORE16
#define ATTN_STORE16(p,v) (*(u32x4*)(p)=(v))
#endif
typedef float f32x4v __attribute__((ext_vector_type(4)));
template<int THRL> __device__ __forceinline__ void attn_unit(int b,int h,int qb,const bf16*Q,const bf16*__restrict__ K,const bf16*__restrict__ V,bf16*O,const float*__restrict__ CUMG,char*shm,const int wave0){
  int lane_; asm volatile("v_mbcnt_lo_u32_b32 %0, -1, 0\n\tv_mbcnt_hi_u32_b32 %0, -1, %0":"=v"(lane_)); const int wid=wave0,tid=wave0*64+lane_,lane=lane_,r32=lane&31,hi=lane>>5;
  const long rowbase=(long)b*SEQ; const int q0=qb*QB;
  const bf16*Qw=Q+(rowbase+q0+wid*QBLK)*DM+h*D;
  const bf16*Kh=K+rowbase*DM+h*D,*Vh=V+rowbase*DM+h*D;
  const unsigned lds0=(unsigned)(uintptr_t)shm;
  float*wsf=(float*)(shm+LDS_WS)+wid*64;
  const bf16*ksrc=Kh+(long)lane*DM+wid*8;
  const bf16*vsrc=Vh+(long)(16*(wid&3)+(lane>>2))*DM+(wid>>2)*32+(lane&3)*8;
  const unsigned kdst=lds0+LDS_K+wid*1024, vdst=lds0+LDS_V+wid*1024;
  #define DMA_K(t,slot) glds16(ksrc+(long)(t)*KVBLK*DM,(unsigned)__builtin_amdgcn_readfirstlane(kdst+(slot)))
  #define DMA_V(t,slot) glds16(vsrc+(long)(t)*KVBLK*DM,(unsigned)__builtin_amdgcn_readfirstlane(vdst+(slot)))
  const int vb0=(int)(lds0+LDS_V)+((lane>>4)&1)*32+(lane&3)*8+(4*hi+((lane&15)>>2))*64;
  const char*Kbase=shm+LDS_K; bf16x8 kf[8];
  const lds_cptr shm3=(lds_cptr)shm; const lds_cptr kp0=shm3+LDS_K+hi*1024+r32*16; const lds_cptr vp0=shm3+LDS_V+((lane>>4)&1)*32+(lane&3)*8+(4*hi+((lane&15)>>2))*64;
  const int NT=(q0+QB)/KVBLK;
  DMA_K(0,0);DMA_V(0,0);DMA_K(1,SLOTB);
  bf16x8 qr[4];
  #pragma unroll
  for(int d0=0;d0<4;++d0)qr[d0]=*reinterpret_cast<const bf16x8*>(&Qw[(long)r32*DM+d0*16+hi*8]);
  { float*cl=(float*)(shm+LDS_CUM); for(int i_=tid;i_<q0+QB;i_+=NW*64)cl[i_]=CUMG[i_]; }
  const float cq=CUMG[q0+wid*QBLK+r32]; float nm=cq;
  const __attribute__((address_space(3))) float* cl3=(const __attribute__((address_space(3))) float*)((lds_cptr)shm+LDS_CUM);
  #define CKLOAD(P0,P1,t) do{ const __attribute__((address_space(3))) float* cb_=cl3+(t)*64+4*hi; \
    _Pragma("unroll") for(int g_=0;g_<4;++g_){ const f32x4v c0_=*(const __attribute__((address_space(3))) f32x4v*)(cb_+8*g_), c1_=*(const __attribute__((address_space(3))) f32x4v*)(cb_+32+8*g_); \
      _Pragma("unroll") for(int j_=0;j_<4;++j_){ P0[4*g_+j_]=c0_[j_]; P1[4*g_+j_]=c1_[j_]; } } }while(0)
  #define CKINIT(P0,P1) do{ _Pragma("unroll") for(int r=0;r<16;++r){P0[r]=nm-P0[r];P1[r]=nm-P1[r];} }while(0)
  float mhat=0.f,l_reg=0.f;f32x16 o[2];o[0]=f32x16{};o[1]=f32x16{};
  const int qrel=wid*QBLK+r32;
  #define CMASK(P0,P1,t) do{int jb_=(t)-(NT-4); if(jb_>=0)cmask(P0,P1,jb_,qrel,hi);}while(0)
  bool resc=false;
  #define START(P0,P1) do{ const float rm=rowmax(P0,P1); resc=false; \
    { const float dl=rm; mhat=fadd_s(mhat,dl); \
      _Pragma("unroll") for(int r=0;r<16;++r){P0[r]=fsub_s(P0[r],dl);P1[r]=fsub_s(P1[r],dl);} \
      nm=cq-mhat; } \
    _Pragma("unroll") for(int r=0;r<16;++r)P0[r]=__builtin_amdgcn_exp2f(P0[r]); }while(0)
  #define RESC() do{ if(resc){ asm volatile("s_waitcnt lgkmcnt(0)":::"memory"); \
      _Pragma("unroll") for(int d_=0;d_<2;++d_) _Pragma("unroll") for(int r=0;r<16;++r)o[d_][r]*=wsf[crow(r,hi)]; } }while(0)
  f32x16 pA0,pA1,pB0,pB1;
  int sl_prev=0,sl_cur=0,sl_next=SLOTB;
  #define ROT() do{sl_prev=sl_cur;sl_cur=sl_next;sl_next=(sl_next==(NSLOT-1)*SLOTB)?0:sl_next+SLOTB;}while(0)
  DMA_K(2,2*SLOTB);
  WAIT_BAR(3);
  CKLOAD(pA0,pA1,0);CKINIT(pA0,pA1);qkt(pA0,pA1,Kbase,qr,r32,hi);asm volatile("s_nop 15\n\ts_nop 7":"+v"(pA0),"+v"(pA1));CMASK(pA0,pA1,0);
  START(pA0,pA1);
  CKLOAD(pB0,pB1,1);
  _Pragma("unroll") for(int r=0;r<16;++r)pA1[r]=__builtin_amdgcn_exp2f(pA1[r]);
  WAIT_BAR(0);
  DMA_K(3,0);DMA_V(1,SLOTB);
  ROT();
  kload8(kf,kp0+sl_cur);
  WAIT_BAR(2);
  s16x4 vlo[8],vhi[8]; u32x4 pw0,pw1,pw2,pw3;
  #define PKW(P,B) cvtpk_s(P[B],P[B+1])
  #define PAF(k) __builtin_bit_cast(bf16x8,pw##k)
  #define VFR(i) (bf16x8){vlo[i][0],vlo[i][1],vlo[i][2],vlo[i][3],vhi[i][0],vhi[i][1],vhi[i][2],vhi[i][3]}
  #define PIN(x) asm volatile("":"+v"(x))
  #define MX3(a,b,c) __builtin_fmaxf(__builtin_fmaxf((a),(b)),(c))
  #define GAPA(MF,A0,A1,A2,A3,W0,W1,PW) do{ MF; sacc+=A0; sacc+=A1; sacc+=A2; sacc+=A3; PIN(sacc); W0; W1; PIN(PW); SBAR(); }while(0)
  #define EX(v) __builtin_amdgcn_exp2f(v)
  #define GAPB(MF,X,B) do{ MF; X[B]=EX(X[B]); X[B+1]=EX(X[B+1]); X[B+2]=EX(X[B+2]); X[B+3]=EX(X[B+3]); PIN(X); SBAR(); }while(0)
  #define VRD(i) do{ vlo[i]=vtr(vp_+(((i)>>2)*4096+((i)&3)*1024)); vhi[i]=vtr(vp_+(((i)>>2)*4096+((i)&3)*1024+512)); }while(0)
  #define KRD(G,j) do{ if(G){ kload2(kf,kp0+sl_next,j); SBAR(); } }while(0)
  #define STEP(C0,C1,P0,P1,t,GK,GV,GL) do{ SBAR(); CKINIT(C0,C1); \
    const lds_cptr vp_=vp0+sl_prev; \
    VRD(0); SBAR(); float sacc=(P0[0]+P0[1]); \
    GAPA(C0=__builtin_amdgcn_mfma_f32_32x32x16_bf16(kf[0],qr[0],C0,0,0,0), P0[2],P0[3],P0[4],P0[5],     pw0[0]=PKW(P0,0), pw0[1]=PKW(P0,2), pw0); \
    VRD(4); SBAR(); GAPA(C1=__builtin_amdgcn_mfma_f32_32x32x16_bf16(kf[1],qr[0],C1,0,0,0), P0[6],P0[7],P0[8],P0[9],     pw0[2]=PKW(P0,4), pw0[3]=PKW(P0,6), pw0); \
    VRD(1); SBAR(); GAPA(C0=__builtin_amdgcn_mfma_f32_32x32x16_bf16(kf[2],qr[1],C0,0,0,0),   P0[10],P0[11],P0[12],P0[13], pw1[0]=PKW(P0,8), pw1[1]=PKW(P0,10), pw1); \
    VRD(5); SBAR(); GAPA(C1=__builtin_amdgcn_mfma_f32_32x32x16_bf16(kf[3],qr[1],C1,0,0,0),   P0[14],P0[15],P1[0],P1[1],   pw1[2]=PKW(P0,12),pw1[3]=PKW(P0,14), pw1); \
    VRD(2); SBAR(); GAPA(C0=__builtin_amdgcn_mfma_f32_32x32x16_bf16(kf[4],qr[2],C0,0,0,0),   P1[2],P1[3],P1[4],P1[5],     pw2[0]=PKW(P1,0), pw2[1]=PKW(P1,2), pw2); \
    VRD(6); SBAR(); GAPA(C1=__builtin_amdgcn_mfma_f32_32x32x16_bf16(kf[5],qr[2],C1,0,0,0),   P1[6],P1[7],P1[8],P1[9],     pw2[2]=PKW(P1,4), pw2[3]=PKW(P1,6), pw2); \
    VRD(3); SBAR(); GAPA(C0=__builtin_amdgcn_mfma_f32_32x32x16_bf16(kf[6],qr[3],C0,0,0,0),   P1[10],P1[11],P1[12],P1[13], pw3[0]=PKW(P1,8), pw3[1]=PKW(P1,10), pw3); \
    VRD(7); SBAR(); GAPA(C1=__builtin_amdgcn_mfma_f32_32x32x16_bf16(kf[7],qr[3],C1,0,0,0),   P1[14],P1[15],0.f,0.f,       pw3[2]=PKW(P1,12),pw3[3]=PKW(P1,14), pw3); \
    l_reg+=sacc; \
    if(GK){DMA_K((t)+3,sl_cur);} if(GV){DMA_V((t)+1,sl_next);} \
    CMASK(C0,C1,t); \
    { float a=MX3(C0[0],C0[1],C1[0]),b=MX3(C0[2],C0[3],C1[1]); a=MX3(a,C1[2],C1[3]); \
      _Pragma("unroll") for(int r=4;r<16;r+=4){a=MX3(a,C0[r],C0[r+1]);b=MX3(b,C0[r+2],C0[r+3]);a=MX3(a,C1[r],C1[r+1]);b=MX3(b,C1[r+2],C1[r+3]);} \
      float rm=__builtin_fmaxf(a,b); { auto rr=__builtin_amdgcn_permlane32_swap(__float_as_uint(rm),__float_as_uint(rm),false,false); rm=__builtin_fmaxf(__uint_as_float(rr[0]),__uint_as_float(rr[1])); } \
      resc=false; \
      if(__builtin_expect(__any(rm>(float)THRL),0)){ const float dl=__builtin_fmaxf(rm,0.f); mhat+=dl; \
        _Pragma("unroll") for(int r=0;r<16;++r){C0[r]-=dl;C1[r]-=dl;} \
        nm=cq-mhat; \
        const float f=__builtin_amdgcn_exp2f(-dl); l_reg*=f; if(hi==0)wsf[r32]=f; resc=true; } } \
    if(GL){ CKLOAD(P0,P1,(t)+1); } \
    SBAR(); \
    GAPB(o[0]=__builtin_amdgcn_mfma_f32_32x32x16_bf16(PAF(0),VFR(0),o[0],0,0,0), C0,0); \
    GAPB(o[1]=__builtin_amdgcn_mfma_f32_32x32x16_bf16(PAF(0),VFR(4),o[1],0,0,0), C0,4); \
    KRD(GL,0); GAPB(o[0]=__builtin_amdgcn_mfma_f32_32x32x16_bf16(PAF(1),VFR(1),o[0],0,0,0), C0,8); \
    KRD(GL,1); GAPB(o[1]=__builtin_amdgcn_mfma_f32_32x32x16_bf16(PAF(1),VFR(5),o[1],0,0,0), C0,12); \
    KRD(GL,2); GAPB(o[0]=__builtin_amdgcn_mfma_f32_32x32x16_bf16(PAF(2),VFR(2),o[0],0,0,0), C1,0); \
    KRD(GL,3); GAPB(o[1]=__builtin_amdgcn_mfma_f32_32x32x16_bf16(PAF(2),VFR(6),o[1],0,0,0), C1,4); \
    GAPB(o[0]=__builtin_amdgcn_mfma_f32_32x32x16_bf16(PAF(3),VFR(3),o[0],0,0,0), C1,8); \
    GAPB(o[1]=__builtin_amdgcn_mfma_f32_32x32x16_bf16(PAF(3),VFR(7),o[1],0,0,0), C1,12); \
    }while(0)
  int t=1;
  #undef CMASK
  #define CMASK(P0,P1,t) do{}while(0)
  for(;t+5<NT;t+=2){
    STEP(pB0,pB1,pA0,pA1,t,true,true,true);     WAIT_BAR(2); RESC(); ROT();
    STEP(pA0,pA1,pB0,pB1,t+1,true,true,true);   WAIT_BAR(2); RESC(); ROT();
  }
  #undef CMASK
  #define CMASK(P0,P1,t) do{int jb_=(t)-(NT-4); if(jb_>=0)cmask(P0,P1,jb_,qrel,hi);}while(0)
  #define ENDW(tt) do{ if((tt)+3<NT){WAIT_BAR(2);} else if((tt)+2<NT){WAIT_BAR(1);} else {WAIT_BAR(0);} }while(0)
  for(;t+1<NT;t+=2){
    STEP(pB0,pB1,pA0,pA1,t,(t+3<NT),(t+1<NT),(t+1<NT));       ENDW(t);   RESC(); ROT();
    STEP(pA0,pA1,pB0,pB1,t+1,(t+4<NT),(t+2<NT),(t+2<NT));     ENDW(t+1); RESC(); ROT();
  }
  STEP(pB0,pB1,pA0,pA1,NT-1,false,false,false); RESC();
  { float sacc=pB0[0]+pB0[1]; _Pragma("unroll") for(int r=2;r<16;++r)sacc+=pB0[r]; _Pragma("unroll") for(int r=0;r<16;++r)sacc+=pB1[r]; l_reg+=sacc;
    pw0=(u32x4){PKW(pB0,0),PKW(pB0,2),PKW(pB0,4),PKW(pB0,6)};pw1=(u32x4){PKW(pB0,8),PKW(pB0,10),PKW(pB0,12),PKW(pB0,14)};pw2=(u32x4){PKW(pB1,0),PKW(pB1,2),PKW(pB1,4),PKW(pB1,6)};pw3=(u32x4){PKW(pB1,8),PKW(pB1,10),PKW(pB1,12),PKW(pB1,14)};
    SBAR(); pv(o,vb0+sl_cur,PAF(0),PAF(1),PAF(2),PAF(3)); }
  #undef PKW
  #undef PAF
  #undef VFR
  #undef PIN
  #undef MX3
  #undef GAPA
  #undef GAPB
  #undef EX
  #undef VRD
  #undef KRD
  #undef STEP
  #undef ENDW
  {auto rr=__builtin_amdgcn_permlane32_swap(__float_as_uint(l_reg),__float_as_uint(l_reg),false,false);l_reg=__uint_as_float(rr[0])+__uint_as_float(rr[1]);}
  if(hi==0)wsf[32+r32]=l_reg;asm volatile("s_waitcnt lgkmcnt(0)":::"memory");
  float rli[16];
  #pragma unroll
  for(int r=0;r<16;++r)rli[r]=__builtin_amdgcn_rcpf(wsf[32+crow(r,hi)]);
  bf16*Ow=O+(rowbase+q0+wid*QBLK)*DM+h*D;
  { bf16*stg=(bf16*)(shm+LDS_OST)+wid*2048;
    #pragma unroll
    for(int r=0;r<16;++r){const int orow=crow(r,hi);
      #pragma unroll
      for(int d0=0;d0<2;++d0)stg[orow*64+d0*32+r32]=__float2bfloat16(o[d0][r]*rli[r]);}
    asm volatile("s_waitcnt lgkmcnt(0)":::"memory");
    #pragma unroll
    for(int i=0;i<4;++i){const int row=i*8+(lane>>3),ch=lane&7; const u32x4 v=*(const u32x4*)(stg+row*64+ch*8); ATTN_STORE16(Ow+(long)row*DM+ch*8,v);} }
  asm volatile("s_waitcnt lgkmcnt(0)\n\ts_barrier":::"memory");
  #undef DMA_K
  #undef DMA_V
  #undef CMASK
  #undef START
  #undef RESC
  #undef CKLOAD
  #undef CKINIT
  #undef ROT
}
constexpr int ATTN_LDS_BYTES=LDS_BYTES;
struct AttnTensors { const bf16* Q; const bf16* K; const bf16* V; bf16* O; const float* CUM; };
struct AttnUnit { int bh; int qb; };
struct StaticOrder {
  int vcu;
  __device__ __forceinline__ explicit StaticOrder(int grid,int block):vcu((block%8)*(grid/8)+block/8){}
  __device__ __forceinline__ bool next(int i,AttnUnit&u)const{ if(i>=4)return false; const int s=2*(vcu&1); u.bh=vcu>>1; u.qb=(i==0)?7-s:(i==1)?s:(i==2)?6-s:s+1; return true; }
  __device__ __forceinline__ void a_ready(const AttnUnit&)const{}
  __device__ __forceinline__ void done(const AttnUnit&)const{}
};
template<class Sched,int THRL=8> __device__ __forceinline__ void attn_phase(char*lds,const AttnTensors&T,const Sched&S,const int wave0){
  AttnUnit u;
  for(int i=0;S.next(i,u);++i){ S.a_ready(u); attn_unit<THRL>(u.bh/NHEAD,u.bh%NHEAD,u.qb,T.Q,T.K,T.V,T.O,T.CUM+(long)u.bh*SEQ,lds,wave0); S.done(u); }
}
#undef SBAR
#undef WAIT_BAR
}
#ifndef XSYNC
#define XSYNC 0
#endif
#ifndef REP_P0
#define REP_P0 1
#endif
#ifndef REP_P1
#define REP_P1 1
#endif
#ifndef REP_P3
#define REP_P3 1
#endif
#ifndef REP_P4
#define REP_P4 1
#endif
#ifndef REP_P5
#define REP_P5 1
#endif
#ifndef REP_P8
#define REP_P8 1
#endif
#define GSYNC() do { xcd_barrier(xbar); for (int xs_ = 0; xs_ < XSYNC; ++xs_) xcd_barrier(xbar); } while (0)
namespace cg = cooperative_groups;
#define LAS __attribute__((address_space(3)))
typedef unsigned short bf16;
typedef unsigned v4u __attribute__((ext_vector_type(4)));
typedef unsigned v2u __attribute__((ext_vector_type(2)));
typedef float f32x4 __attribute__((ext_vector_type(4)));
typedef short bf16x8 __attribute__((ext_vector_type(8)));

constexpr int NWAVES = 8, NTHR = 512;
constexpr int M = 16384, DMODEL = 1024, SEQ = 2048, NBATCH = 8, NHEAD = 16, FF = 2816, NUP = 5632, PLED = 256, NIN = 7168, NINF = 7184;
constexpr float EPS = 1e-6f, LOG2E = 1.4426950408889634f;
constexpr size_t MiB = 1u << 20;
constexpr size_t WS_CTL = 0, WS_WIN = 1 * MiB, WS_WA = 15 * MiB, WS_WB = 17 * MiB, WS_WOUT = 19 * MiB, WS_WUP = 21 * MiB, WS_WDN = 32 * MiB,
                 WS_WPLE = 37 * MiB + 512 * 1024, WS_WPG = 38 * MiB, WS_WS = 40 * MiB, WS_LF = 41 * MiB, WS_CUM = 42 * MiB,
                 WS_SS1 = 43 * MiB, WS_SS2 = 43 * MiB + 256 * 1024, WS_SS3 = 43 * MiB + 512 * 1024,
                 WS_PB = 44 * MiB, WS_XN = 52 * MiB, WS_U = 84 * MiB, WS_V = 116 * MiB, WS_Q = 148 * MiB, WS_K = 180 * MiB, WS_VA = 212 * MiB, WS_END = 244 * MiB;
constexpr size_t WS_TMP = WS_K, WS_MRG = WS_V, WS_X1 = WS_K, WS_ACT = WS_U, WS_PLEB = WS_U;
constexpr int RING_BYTES = 131072, LDS_BYTES = 147456;

__device__ __forceinline__ unsigned f2bf(float f) { unsigned u = __builtin_bit_cast(unsigned, f); return (u + 0x7fffu + ((u >> 16) & 1u)) >> 16; }
__device__ __forceinline__ unsigned pk2(float lo, float hi) { return pg8::cvt_pk_bf16(lo, hi); }
__device__ __forceinline__ float bflo(unsigned w) { return __uint_as_float(w << 16); }
__device__ __forceinline__ float bfhi(unsigned w) { return __uint_as_float(w & 0xffff0000u); }
__device__ __forceinline__ float sigm(float x) { return __builtin_amdgcn_rcpf(1.0f + __builtin_amdgcn_exp2f(-LOG2E * x)); }
__device__ __forceinline__ float gelu_t(float x) { const float u = x * (1.5957691216f + 0.0713548163f * x * x); return x * __builtin_amdgcn_rcpf(1.0f + __builtin_amdgcn_exp2f(-LOG2E * u)); }
__device__ __forceinline__ float wave_sum(float v) {
#pragma unroll
    for (int o = 1; o < 64; o <<= 1) v += __shfl_xor(v, o);
    return v;
}
#define LDS_WAIT() asm volatile("s_waitcnt lgkmcnt(0)" ::: "memory")
#define VM_WAIT() asm volatile("s_waitcnt vmcnt(0)" ::: "memory")

__device__ __forceinline__ void transpose_item(const float* W, int Nsrc, int src_col0, int k0, bf16* WT, int K, int dst_row0, const float* kscale, LAS float* scr, int lane) {
#pragma unroll 8
    for (int i = 0; i < 32; ++i) { const int kk = 2 * i + (lane >> 5); float v = W[(size_t)(k0 + kk) * Nsrc + src_col0 + (lane & 31)]; if (kscale) v *= kscale[k0 + kk]; scr[kk * 33 + (lane & 31)] = v; }
    LDS_WAIT(); asm volatile("" ::: "memory");
    const int c = lane & 7;
#pragma unroll
    for (int j = 0; j < 4; ++j) { const int n = (lane >> 3) + 8 * j; const LAS float* s = scr + (8 * c) * 33 + n;
        v4u o; o.x = pk2(s[0 * 33], s[1 * 33]); o.y = pk2(s[2 * 33], s[3 * 33]); o.z = pk2(s[4 * 33], s[5 * 33]); o.w = pk2(s[6 * 33], s[7 * 33]);
        *(v4u*)(WT + (size_t)(dst_row0 + n) * K + k0 + 8 * c) = o; }
    LDS_WAIT(); asm volatile("" ::: "memory");
}

typedef __attribute__((address_space(1))) unsigned gu32;
#define RLX_AGENT __ATOMIC_RELAXED, __HIP_MEMORY_SCOPE_AGENT
#define XB_TMO      128
#define XB_XCNT(j)  (256  + 64 * (j))
#define XB_XSUB(j)  (1280 + 64 * (j))
#define XB_XGEN(j)  (2304 + 64 * (j))
#define XB_TOP      3328
#define XB_TOPGEN   3392
#define XCD_BAR_WORDS 3456
#define XB_SPIN_CAP (1u << 18)

__device__ __forceinline__ unsigned xb_ld(unsigned* p)              { return __hip_atomic_load(p, __ATOMIC_RELAXED, __HIP_MEMORY_SCOPE_AGENT); }
__device__ __forceinline__ unsigned xb_add(unsigned* p, unsigned v) { return __hip_atomic_fetch_add(p, v, __ATOMIC_RELAXED, __HIP_MEMORY_SCOPE_AGENT); }
__device__ __forceinline__ unsigned xb_xcc_id() { return (unsigned)__builtin_amdgcn_s_getreg((3 << 11) | 20) & 0xFu; }
#define XB_SPIN(cond, bar) do { unsigned _sp = 0; while (cond) { __builtin_amdgcn_s_sleep(1); \
    if ((++_sp & 255u) == 0u) { if (xb_ld(&(bar)[XB_TMO])) break; if (_sp > XB_SPIN_CAP) { atomicAdd(&(bar)[XB_TMO], 1u); break; } } } } while (0)

struct XcdBarrier {
    unsigned* bar; unsigned x;
    volatile LAS unsigned* st;
};

__device__ __forceinline__ XcdBarrier xcd_barrier_post(unsigned* bar, volatile LAS unsigned* st) {
    XcdBarrier b; b.bar = bar; b.x = xb_xcc_id(); b.st = st;
    if (threadIdx.x == 0) (void)xb_add(&bar[XB_XCNT(b.x)], 1u);
    return b;
}
__device__ __forceinline__ void xcd_barrier_complete(unsigned* bar, unsigned x, unsigned& nloc, unsigned& nx) {
    const unsigned G = gridDim.x * gridDim.y * gridDim.z;
    unsigned sum, cnt, mine, sp = 0u;
    for (;;) {
        sum = 0u; cnt = 0u; mine = 0u;
#pragma unroll
        for (unsigned j = 0; j < 16; ++j) { const unsigned c = xb_ld(&bar[XB_XCNT(j)]); sum += c; cnt += (c > 0u) ? 1u : 0u; mine = (j == x) ? c : mine; }
        if (sum == G) break;
        __builtin_amdgcn_s_sleep(1);
        if ((++sp & 255u) == 0u) { if (xb_ld(&bar[XB_TMO])) break; if (sp > XB_SPIN_CAP) { atomicAdd(&bar[XB_TMO], 1u); break; } }
    }
    nloc = mine > 0u ? mine : 1u; nx = cnt > 0u ? cnt : 1u;
}

__device__ __forceinline__ void xcd_barrier(const XcdBarrier& b) {
    asm volatile("s_waitcnt vmcnt(0)" ::: "memory");
    __syncthreads();
    if (threadIdx.x == 0) {
        unsigned* bar = b.bar;
        __builtin_amdgcn_s_waitcnt(0);
        unsigned nloc = b.st[0], nx = b.st[1];
        if (nloc == 0u) { xcd_barrier_complete(bar, b.x, nloc, nx); b.st[0] = nloc; b.st[1] = nx; }
        const unsigned old = xb_add(&bar[XB_XSUB(b.x)], 1u);
        const unsigned gen = old / nloc;
        if (old + 1u == (gen + 1u) * nloc) {
            __builtin_amdgcn_fence(__ATOMIC_RELEASE, "agent");
            asm volatile("s_waitcnt vmcnt(0)" ::: "memory");
            const unsigned og = xb_add(&bar[XB_TOP], 1u);
            const unsigned tg = og / nx;
            if (og + 1u == (tg + 1u) * nx) xb_add(&bar[XB_TOPGEN], 1u);
            else XB_SPIN(xb_ld(&bar[XB_TOPGEN]) == tg, bar);
            __builtin_amdgcn_fence(__ATOMIC_ACQUIRE, "agent");
            xb_add(&bar[XB_XGEN(b.x)], 1u);
            asm volatile("s_waitcnt vmcnt(0)" ::: "memory");
        } else {
            XB_SPIN(xb_ld(&bar[XB_XGEN(b.x)]) == gen, bar);
            __builtin_amdgcn_fence(__ATOMIC_ACQUIRE, "agent");
            asm volatile("s_waitcnt vmcnt(0)" ::: "memory");
        }
    }
    __syncthreads();
}

struct Args { const float* in[21]; float* out; unsigned char* ws; };

struct SegOrder {
    pg8::StaticOrder S; int nseg;
    __device__ bool next(int i, pg8::Unit& u) const { const bool ok = S.next(i / nseg, u); u.seg = i % nseg; return ok; }
    __device__ __forceinline__ void a_ready(const pg8::Unit&) const {}
    __device__ __forceinline__ void done(const pg8::Unit&) const {}
};

struct EpiIn {
    static constexpr bool PERM = true, AFTER_DRAIN = false;
    bf16* Z; bf16* G;
    __device__ __forceinline__ void operator()(const pg8::f32x4 (&acc)[2][2][4][2], const pg8::Unit& u, int wr, int wc, int fr, int fq) const {
        const int grp = u.pn >> 2;
        bf16* base = grp < 5 ? Z + (size_t)grp * M * 1024 : G + (size_t)(grp - 5) * M * 1024;
        const int row0 = u.pm * 256 + wr * 64 + fr, col0 = (u.pn & 3) * 256 + wc * 32 + 8 * fq;
#pragma unroll
        for (int ai = 0; ai < 2; ++ai)
#pragma unroll
            for (int m = 0; m < 4; ++m) { const unsigned ro = (unsigned)((row0 + ai * 128 + m * 16) * 1024 + col0) * 2u;
#pragma unroll
                for (int bj = 0; bj < 2; ++bj) { f32x4 v0 = acc[ai][bj][m][0], v1 = acc[ai][bj][m][1];
                    if (grp < 2) {
#pragma unroll
                        for (int j = 0; j < 4; ++j) { v0[j] = gelu_t(v0[j]); v1[j] = gelu_t(v1[j]); }
                    } else if (grp == 2) { v0 = v0 * attn_body::C2; v1 = v1 * attn_body::C2; }
                    else if (grp >= 5) {
#pragma unroll
                        for (int j = 0; j < 4; ++j) { v0[j] = sigm(v0[j]); v1[j] = sigm(v1[j]); }
                    }
                    v4u w; w.x = pk2(v0[0], v0[1]); w.y = pk2(v0[2], v0[3]); w.z = pk2(v1[0], v1[1]); w.w = pk2(v1[2], v1[3]);
                    *(v4u*)((char*)base + (size_t)(ro + (unsigned)(bj * 256))) = w; } }
    }
};

struct EpiMerge {
    static constexpr bool PERM = true, AFTER_DRAIN = false;
    const bf16* GA; const bf16* GB; float* TMP; bf16* MRG;
    __device__ __forceinline__ void operator()(const pg8::f32x4 (&acc)[2][2][4][2], const pg8::Unit& u, int wr, int wc, int fr, int fq) const {
        const int row0 = u.pm * 256 + wr * 64 + fr, col0 = u.pn * 256 + wc * 32 + 8 * fq;
        const bf16* gp = u.seg ? GB : GA;
#pragma unroll
        for (int ai = 0; ai < 2; ++ai)
#pragma unroll
            for (int m = 0; m < 4; ++m) { const unsigned off = (unsigned)((row0 + ai * 128 + m * 16) * 1024 + col0);
#pragma unroll
                for (int bj = 0; bj < 2; ++bj) { const v4u gw = *(const v4u*)((const char*)gp + (size_t)((off + bj * 128) * 2u));
                    f32x4 g0 = {bflo(gw.x), bfhi(gw.x), bflo(gw.y), bfhi(gw.y)}, g1 = {bflo(gw.z), bfhi(gw.z), bflo(gw.w), bfhi(gw.w)};
                    f32x4 v0 = acc[ai][bj][m][0] * g0, v1 = acc[ai][bj][m][1] * g1;
                    float* tp = (float*)((char*)TMP + (size_t)((off + bj * 128) * 4u));
                    if (u.seg == 0) { *(f32x4*)tp = v0; *(f32x4*)(tp + 4) = v1; }
                    else { v0 += *(const f32x4*)tp; v1 += *(const f32x4*)(tp + 4);
                        v4u w; w.x = pk2(v0[0], v0[1]); w.y = pk2(v0[2], v0[3]); w.z = pk2(v1[0], v1[1]); w.w = pk2(v1[2], v1[3]);
                        *(v4u*)((char*)MRG + (size_t)((off + bj * 128) * 2u)) = w; } } }
    }
};

struct EpiResid {
    static constexpr bool PERM = false, AFTER_DRAIN = true;
    const float* base; float* out; bf16* outb; float* SS;
    __device__ __forceinline__ void fused(pg8::f32x4 (&acc)[2][2][4][2], const pg8::Unit& u, int wr, int wc, int fr, int fq, PG8_LAS unsigned char* lds, int wid, int lane) const {
        PG8_LAS float* P = (PG8_LAS float*)lds;
        const int col0 = u.pn * 256 + wc * 32 + 4 * fq;
#pragma unroll
        for (int ai = 0; ai < 2; ++ai)
#pragma unroll
            for (int m = 0; m < 4; ++m) { const int r = ai * 128 + wr * 64 + m * 16 + fr; const size_t off = (size_t)(u.pm * 256 + r) * 1024 + col0; float q = 0.f;
#pragma unroll
                for (int bj = 0; bj < 2; ++bj)
#pragma unroll
                    for (int n = 0; n < 2; ++n) { const f32x4 o = *(const f32x4*)(base + off + bj * 128 + n * 16) + acc[ai][bj][m][n];
                        *(f32x4*)(out + off + bj * 128 + n * 16) = o; v2u w; w.x = pk2(o[0], o[1]); w.y = pk2(o[2], o[3]); *(v2u*)(outb + off + bj * 128 + n * 16) = w;
                        q += (o[0] * o[0] + o[1] * o[1]) + (o[2] * o[2] + o[3] * o[3]); }
                q += __shfl_xor(q, 16); q += __shfl_xor(q, 32);
                if (fq == 0) P[r * 4 + wc] = q;
                asm volatile("" ::: "memory"); }
        LDS_WAIT(); __builtin_amdgcn_s_barrier(); asm volatile("" ::: "memory");
        const int t = wid * 64 + lane;
        if (t < 256) { const f32x4 p = *(const PG8_LAS f32x4*)(P + t * 4); SS[(size_t)(u.pm * 256 + t) * 4 + u.pn] = (p[0] + p[1]) + (p[2] + p[3]); }
        LDS_WAIT(); __builtin_amdgcn_s_barrier(); asm volatile("" ::: "memory");
    }
};

struct EpiPlain {
    static constexpr bool PERM = false, AFTER_DRAIN = false;
    bf16* O;
    __device__ __forceinline__ void operator()(const pg8::f32x4 (&acc)[2][2][4][2], const pg8::Unit& u, int wr, int wc, int fr, int fq) const {
        const int col0 = u.pn * 256 + wc * 32 + 4 * fq;
#pragma unroll
        for (int ai = 0; ai < 2; ++ai)
#pragma unroll
            for (int m = 0; m < 4; ++m) { const size_t off = (size_t)(u.pm * 256 + ai * 128 + wr * 64 + m * 16 + fr) * 1024 + col0;
#pragma unroll
                for (int bj = 0; bj < 2; ++bj)
#pragma unroll
                    for (int n = 0; n < 2; ++n) { const f32x4 o = acc[ai][bj][m][n]; v2u w; w.x = pk2(o[0], o[1]); w.y = pk2(o[2], o[3]); *(v2u*)(O + off + bj * 128 + n * 16) = w; } }
    }
};

struct EpiPleGate {
    static constexpr bool PERM = false, AFTER_DRAIN = true;
    const float* base; const bf16* PLE; const float* SSin; float* out; float* SS;
    __device__ __forceinline__ void fused(pg8::f32x4 (&acc)[2][2][4][2], const pg8::Unit& u, int wr, int wc, int fr, int fq, PG8_LAS unsigned char* lds, int wid, int lane) const {
        PG8_LAS float* P = (PG8_LAS float*)lds;
        const int col0 = u.pn * 256 + wc * 32 + 4 * fq;
#pragma unroll
        for (int ai = 0; ai < 2; ++ai)
#pragma unroll
            for (int m = 0; m < 4; ++m) { const int r = ai * 128 + wr * 64 + m * 16 + fr; const size_t row = (size_t)(u.pm * 256 + r); const size_t off = row * 1024 + col0; float q = 0.f;
                const f32x4 s4 = *(const f32x4*)(SSin + row * 4); const float rstd = 1.0f / sqrtf(((s4[0] + s4[1]) + (s4[2] + s4[3])) * (1.0f / 1024.0f) + EPS);
#pragma unroll
                for (int bj = 0; bj < 2; ++bj)
#pragma unroll
                    for (int n = 0; n < 2; ++n) { const size_t o2 = off + bj * 128 + n * 16; const f32x4 b = *(const f32x4*)(base + o2); const v2u pw = *(const v2u*)(PLE + o2);
                        const f32x4 a = acc[ai][bj][m][n] * rstd; f32x4 o;
                        o[0] = b[0] + bflo(pw.x) * sigm(a[0]); o[1] = b[1] + bfhi(pw.x) * sigm(a[1]); o[2] = b[2] + bflo(pw.y) * sigm(a[2]); o[3] = b[3] + bfhi(pw.y) * sigm(a[3]);
                        *(f32x4*)(out + o2) = o; q += (o[0] * o[0] + o[1] * o[1]) + (o[2] * o[2] + o[3] * o[3]); }
                q += __shfl_xor(q, 16); q += __shfl_xor(q, 32);
                if (fq == 0) P[r * 4 + wc] = q;
                asm volatile("" ::: "memory"); }
        LDS_WAIT(); __builtin_amdgcn_s_barrier(); asm volatile("" ::: "memory");
        const int t = wid * 64 + lane;
        if (t < 256) { const f32x4 p = *(const PG8_LAS f32x4*)(P + t * 4); SS[(size_t)(u.pm * 256 + t) * 4 + u.pn] = (p[0] + p[1]) + (p[2] + p[3]); }
        LDS_WAIT(); __builtin_amdgcn_s_barrier(); asm volatile("" ::: "memory");
    }
};

template <int CTRL> __device__ __forceinline__ float dpp_ror(float v) { return __builtin_bit_cast(float, __builtin_amdgcn_update_dpp(0, __builtin_bit_cast(int, v), CTRL, 0xf, 0xf, false)); }
struct EpiUp {
    static constexpr bool PERM = true, AFTER_DRAIN = false;
    const float* SSin; const float* cw; const float* cbias; bf16* ACT; float* RAWB;
    __device__ __forceinline__ void operator()(const pg8::f32x4 (&acc)[2][2][4][2], const pg8::Unit& u, int wr, int wc, int fr, int fq) const {
        const int ch0 = u.pn * 128 + wc * 32 + 8 * fq;
        const bool l15 = fr == 15, l14 = fr >= 14;
#pragma unroll
        for (int ai = 0; ai < 2; ++ai) {
            const int rowb = u.pm * 256 + ai * 128 + wr * 64;
            const int rb = rowb >> 6;
            float rstd[4];
#pragma unroll
            for (int m = 0; m < 4; ++m) { const f32x4 s4 = *(const f32x4*)((const char*)SSin + (size_t)(unsigned)((rowb + m * 16 + fr) * 16)); rstd[m] = 1.0f / sqrtf(((s4[0] + s4[1]) + (s4[2] + s4[3])) * (1.0f / 1024.0f) + EPS); }
#pragma unroll
            for (int n = 0; n < 2; ++n) {
                float gg[4][4];
#pragma unroll
                for (int bj = 0; bj < 2; ++bj) {
                    const int cc = bj * FF + ch0 + 4 * n;
                    const unsigned co = (unsigned)cc * 4u;
                    const f32x4 w0 = *(const f32x4*)((const char*)cw + (size_t)co), w1 = *(const f32x4*)((const char*)cw + (size_t)(co + NUP * 4u)), w2 = *(const f32x4*)((const char*)cw + (size_t)(co + NUP * 8u)), bb = *(const f32x4*)((const char*)cbias + (size_t)co);
                    f32x4 s[4];
#pragma unroll
                    for (int m = 0; m < 4; ++m) s[m] = acc[ai][bj][m][n] * rstd[m];
                    { const unsigned ro = (unsigned)((rb * 4) * NUP + u.pn * 256 + bj * 128 + wc * 32 + 8 * fq + 4 * n) * 4u;
                      if (fr < 2) *(f32x4*)((char*)RAWB + (size_t)(ro + (unsigned)(fr * NUP * 4))) = s[0];
                      if (fr >= 14) *(f32x4*)((char*)RAWB + (size_t)(ro + (unsigned)((fr - 12) * NUP * 4))) = s[3]; }
#pragma unroll
                    for (int m = 0; m < 4; ++m)
#pragma unroll
                        for (int j = 0; j < 4; ++j) {
                            const float cur = s[m][j], prv = m > 0 ? s[m - 1][j] : 0.f;
                            const float p1 = dpp_ror<0x121>(l15 ? prv : cur), p2 = dpp_ror<0x122>(l14 ? prv : cur);
                            const float cvv = bb[j] + w0[j] * p2 + w1[j] * p1 + w2[j] * cur;
                            if (bj == 0) gg[m][j] = gelu_t(cvv); else gg[m][j] *= cvv;
                        }
                    asm volatile("" ::: "memory"); __builtin_amdgcn_sched_barrier(0);
                }
#pragma unroll
                for (int m = 0; m < 4; ++m) {
                    v2u w; w.x = pk2(gg[m][0], gg[m][1]); w.y = pk2(gg[m][2], gg[m][3]);
                    if (m > 0 || fr >= 2) *(v2u*)((char*)ACT + (size_t)(unsigned)(((rowb + m * 16 + fr) * FF + ch0 + 4 * n) * 2)) = w;
                }
                asm volatile("" ::: "memory"); __builtin_amdgcn_sched_barrier(0);
            }
        }
    }
};

__global__ void __launch_bounds__(NTHR, 2) fwd_mega(Args args) {
    extern __shared__ __attribute__((aligned(16))) unsigned char lds_raw[];
    cg::grid_group grid = cg::this_grid();
    LAS unsigned char* lds = (LAS unsigned char*)lds_raw;
const int wave0 = __builtin_amdgcn_readfirstlane(threadIdx.x >> 6);
#define FRESH_TID() int lane_; asm volatile("v_mbcnt_lo_u32_b32 %0, -1, 0\n\tv_mbcnt_hi_u32_b32 %0, -1, %0" : "=v"(lane_)); const int lane = lane_, wave = wave0, tid = wave0 * 64 + lane_; const int gw = vcu * NWAVES + wave, NGW = G * NWAVES; (void)lane; (void)gw; (void)NGW
    const int G = gridDim.x, bx = blockIdx.x;
    const int vcu = (G % 8 == 0) ? (bx % 8) * (G / 8) + bx / 8 : bx;
    unsigned char* ws = args.ws;
    const float* x = args.in[0];
    bf16* Win_t = (bf16*)(ws + WS_WIN); bf16* Wa_t = (bf16*)(ws + WS_WA); bf16* Wb_t = (bf16*)(ws + WS_WB); bf16* Wout_t = (bf16*)(ws + WS_WOUT);
    bf16* Wup_t = (bf16*)(ws + WS_WUP); bf16* Wdn_t = (bf16*)(ws + WS_WDN); bf16* Wple_t = (bf16*)(ws + WS_WPLE); bf16* Wpg_t = (bf16*)(ws + WS_WPG); bf16* Wsm = (bf16*)(ws + WS_WS);
    float* LF = (float*)(ws + WS_LF); float* CUM = (float*)(ws + WS_CUM);
    float* SS1 = (float*)(ws + WS_SS1); float* SS2 = (float*)(ws + WS_SS2); float* SS3 = (float*)(ws + WS_SS3);
    bf16* PB = (bf16*)(ws + WS_PB); bf16* XN = (bf16*)(ws + WS_XN);
    bf16* ZU = (bf16*)(ws + WS_U); bf16* ZV = (bf16*)(ws + WS_V); bf16* ZQ = (bf16*)(ws + WS_Q); bf16* ZK = (bf16*)(ws + WS_K); bf16* ZVA = (bf16*)(ws + WS_VA);
    bf16* GA = (bf16*)args.out; bf16* GB = GA + (size_t)M * 1024;
    float* TMP = (float*)(ws + WS_TMP); bf16* MRG = (bf16*)(ws + WS_MRG); float* X1 = (float*)(ws + WS_X1); bf16* ACT = (bf16*)(ws + WS_ACT); bf16* PLEB = (bf16*)(ws + WS_PLEB);
    float* RAWB = args.out;

    for (int rep_ = 0; rep_ < REP_P0; ++rep_) {
        FRESH_TID();
        LAS float* scr = (LAS float*)(lds + wave * 16384);
        constexpr int I_IN = 16 * (NIN / 32), I_SQ = 16 * 32, I_UP = 16 * (NUP / 32), I_DN = (FF / 64) * 32, I_PLE = (PLED / 64) * 32;
        constexpr int NITEMS = I_IN + 4 * I_SQ + I_UP + I_DN + I_PLE;
        for (int it = gw; it < NITEMS; it += NGW) {
            int r = it;
            if (r < I_IN) { const int nb = r % (NIN / 32), kb = r / (NIN / 32), n0 = nb * 32; transpose_item(args.in[3], NINF, n0 < 5120 ? n0 : n0 + 16, kb * 64, Win_t, 1024, n0, nullptr, scr, lane); continue; } r -= I_IN;
            if (r < 4 * I_SQ) { const int w = r / I_SQ, q = r % I_SQ, nb = q % 32, kb = q / 32;
                const float* src = w == 0 ? args.in[9] : w == 1 ? args.in[10] : w == 2 ? args.in[11] : args.in[19]; bf16* dst = w == 0 ? Wa_t : w == 1 ? Wb_t : w == 2 ? Wout_t : Wpg_t;
                transpose_item(src, 1024, nb * 32, kb * 64, dst, 1024, nb * 32, w == 3 ? args.in[17] : nullptr, scr, lane); continue; } r -= 4 * I_SQ;
            if (r < I_UP) { const int nb = r % (NUP / 32), kb = r / (NUP / 32), n0 = nb * 32, pn = n0 >> 8, wi = n0 & 255;
                transpose_item(args.in[13], NUP, (wi >> 7) * FF + pn * 128 + (wi & 127), kb * 64, Wup_t, 1024, n0, args.in[12], scr, lane); continue; } r -= I_UP;
            if (r < I_DN) { const int nb = r % 32, kb = r / 32; transpose_item(args.in[16], 1024, nb * 32, kb * 64, Wdn_t, FF, nb * 32, nullptr, scr, lane); continue; } r -= I_DN;
            { const int nb = r % 32, kb = r / 32; transpose_item(args.in[18], 1024, nb * 32, kb * 64, Wple_t, PLED, nb * 32, nullptr, scr, lane); }
        }
        if (bx == 0) for (int i = tid; i < XCD_BAR_WORDS; i += NTHR) ((unsigned*)(ws + WS_CTL) + 1024)[i] = 0u;
        if (tid == 0) { ((volatile LAS unsigned*)(lds + RING_BYTES + 512))[0] = 0u; ((volatile LAS unsigned*)(lds + RING_BYTES + 512))[1] = 0u; }
        for (int i = bx * NTHR + tid; i < 8 * 128 * 128; i += G * NTHR) { const int s = i & 127, t = (i >> 7) & 127; Wsm[i] = (bf16)f2bf((s >> 6) <= (t >> 6) ? args.in[7][i] : 0.f); }
        for (int i = bx * NTHR + tid; i < M * PLED / 4; i += G * NTHR) { const f32x4 v = ((const f32x4*)args.in[1])[i]; v2u w; w.x = pk2(v[0], v[1]); w.y = pk2(v[2], v[3]); ((v2u*)PB)[i] = w; }
        __syncthreads();
        LAS float* wf = (LAS float*)lds;
        for (int i = tid; i < 16 * 1024; i += NTHR) { const int hh = i & 15, k = i >> 4; wf[hh * 1024 + k] = args.in[3][(size_t)k * NINF + 5120 + hh]; }
        __syncthreads();
        const float* gmix = args.in[2];
        for (int m = gw; m < M; m += NGW) {
            const f32x4* xr = (const f32x4*)(x + (size_t)m * 1024) + lane;
            f32x4 v[4]; float s2 = 0.f;
#pragma unroll
            for (int j = 0; j < 4; ++j) { v[j] = xr[64 * j]; s2 += (v[j][0] * v[j][0] + v[j][1] * v[j][1]) + (v[j][2] * v[j][2] + v[j][3] * v[j][3]); }
            const float rstd = 1.0f / sqrtf(wave_sum(s2) * (1.0f / 1024.0f) + EPS);
            v2u* o8 = (v2u*)(XN + (size_t)m * 1024) + lane;
#pragma unroll
            for (int j = 0; j < 4; ++j) { const f32x4 g4 = ((const f32x4*)gmix)[lane + 64 * j]; v[j] = v[j] * rstd * g4; v2u w; w.x = pk2(v[j][0], v[j][1]); w.y = pk2(v[j][2], v[j][3]); o8[64 * j] = w; }
            float mine = 0.f;
#pragma unroll 4
            for (int hh = 0; hh < 16; ++hh) { float d = 0.f;
#pragma unroll
                for (int j = 0; j < 4; ++j) { const f32x4 w4 = *(const LAS f32x4*)(wf + hh * 1024 + 4 * lane + 256 * j); d += (v[j][0] * w4[0] + v[j][1] * w4[1]) + (v[j][2] * w4[2] + v[j][3] * w4[3]); }
                d = wave_sum(d); if (lane == hh) mine = d; }
            if (lane < 16) { const float z = mine + args.in[4][lane]; const float ls = fminf(z, 0.f) - log1pf(expf(-fabsf(z)));
                LF[((size_t)(m / SEQ) * 16 + lane) * SEQ + (m % SEQ)] = ls * LOG2E; }
        }
    }
    grid.sync();
    XcdBarrier xbar = xcd_barrier_post((unsigned*)(ws + WS_CTL) + 1024, (volatile LAS unsigned*)(lds + RING_BYTES + 512));

    for (int rep_ = 0; rep_ < REP_P1; ++rep_) {
        FRESH_TID();
        if (bx < NBATCH * NHEAD) {
            LAS float* wsum = (LAS float*)lds;
            f32x4 v = *(const f32x4*)(LF + (size_t)bx * SEQ + 4 * tid);
            v[1] += v[0]; v[2] += v[1]; v[3] += v[2];
            const float tot = v[3]; float inc = tot;
#pragma unroll
            for (int o = 1; o < 64; o <<= 1) { const float n = __shfl_up(inc, o); if (lane >= o) inc += n; }
            if (lane == 63) wsum[wave] = inc;
            __syncthreads();
            float pre = 0.f;
            for (int w = 0; w < wave; ++w) pre += wsum[w];
            const float ex = inc - tot + pre;
            v = v + ex;
            *(f32x4*)(CUM + (size_t)bx * SEQ + 4 * tid) = v;
            __syncthreads();
        }
        pg8::Gemm g{XN, Win_t, M, NIN, 1024, XN, Win_t}; pg8::StaticOrder S; S.init(M, NIN, G, bx);
        EpiIn E{ZU, GA};
#ifndef SKIP_IN
        pg8::gemm_phase<EpiIn, pg8::StaticOrder, true, true>(lds, g, S, E, wave0);
#endif
    }
    GSYNC();

    {
        FRESH_TID();
        const attn_body::AttnTensors AT{(const attn_body::bf16*)ZQ, (const attn_body::bf16*)ZK, (const attn_body::bf16*)ZVA, (attn_body::bf16*)ZQ, CUM};
        const attn_body::StaticOrder S(G, bx);
#ifndef SKIP_ATTN
        attn_body::attn_phase<attn_body::StaticOrder>((char*)lds_raw, AT, S, wave0);
#endif
        __syncthreads();
        const int bn = vcu >> 1, g0 = (vcu & 1) * 4, R0 = bn * 128;
        LAS float* stat = (LAS float*)lds;
        LAS bf16* vT = (LAS bf16*)(lds + 1024);
        const int fr = lane & 15, fq = lane >> 4;
        for (int r = 0; r < 16; ++r) {
            const v4u* vp = (const v4u*)(ZV + (size_t)(R0 + 16 * wave + r) * 1024) + lane;
            const v4u a = vp[0], b = vp[64]; float s = 0.f, q = 0.f;
#pragma unroll
            for (int e = 0; e < 4; ++e) { const float x0 = bflo(a[e]), x1 = bfhi(a[e]), x2 = bflo(b[e]), x3 = bfhi(b[e]); s += (x0 + x1) + (x2 + x3); q += (x0 * x0 + x1 * x1) + (x2 * x2 + x3 * x3); }
            s = wave_sum(s); q = wave_sum(q);
            const float mean = s * (1.0f / 1024.0f), var = fmaxf(q * (1.0f / 1024.0f) - mean * mean, 0.f);
            if (lane == 0) { stat[2 * (16 * wave + r)] = mean; stat[2 * (16 * wave + r) + 1] = 1.0f / sqrtf(var + EPS); }
        }
        __syncthreads();
        for (int gi = 0; gi < 4; ++gi) {
            const int g = g0 + gi;
            { const int cc = tid & 15;
              f32x4 lg0 = *(const f32x4*)(args.in[5] + 128 * g + 8 * cc), lg1 = *(const f32x4*)(args.in[5] + 128 * g + 8 * cc + 4);
              f32x4 lb0 = *(const f32x4*)(args.in[6] + 128 * g + 8 * cc), lb1 = *(const f32x4*)(args.in[6] + 128 * g + 8 * cc + 4);
#pragma unroll
              for (int i = 0; i < 4; ++i) { const int s = (tid >> 4) + 32 * i; const v4u raw = *(const v4u*)(ZV + (size_t)(R0 + s) * 1024 + 128 * g + 8 * cc);
                  const float mean = stat[2 * s], rstd = stat[2 * s + 1];
#pragma unroll
                  for (int e = 0; e < 4; ++e) { const float y0 = (bflo(raw[e]) - mean) * rstd * (e < 2 ? lg0[2 * e] : lg1[2 * e - 4]) + (e < 2 ? lb0[2 * e] : lb1[2 * e - 4]);
                      const float y1 = (bfhi(raw[e]) - mean) * rstd * (e < 2 ? lg0[2 * e + 1] : lg1[2 * e - 3]) + (e < 2 ? lb0[2 * e + 1] : lb1[2 * e - 3]);
                      vT[(8 * cc + 2 * e) * 136 + s] = (bf16)f2bf(y0); vT[(8 * cc + 2 * e + 1) * 136 + s] = (bf16)f2bf(y1); } } }
            __syncthreads();
            f32x4 acc[8];
#pragma unroll
            for (int nb = 0; nb < 8; ++nb) acc[nb] = (f32x4){0.f, 0.f, 0.f, 0.f};
            const int kmax = wave < 4 ? 2 : 4;
            for (int k = 0; k < kmax; ++k) {
                const bf16x8 afr = *(const bf16x8*)(Wsm + (size_t)(g * 128 + 16 * wave + fr) * 128 + 32 * k + 8 * fq);
#pragma unroll
                for (int nb = 0; nb < 8; ++nb) { const bf16x8 bfr = *(const LAS bf16x8*)(vT + (16 * nb + fr) * 136 + 32 * k + 8 * fq);
                    acc[nb] = __builtin_amdgcn_mfma_f32_16x16x32_bf16(bfr, afr, acc[nb], 0, 0, 0); }
            }
            const int t = 16 * wave + fr; const float bias = args.in[8][g * 128 + t];
#pragma unroll
            for (int nb = 0; nb < 8; ++nb) { v2u* up = (v2u*)(ZU + (size_t)(R0 + t) * 1024 + 128 * g + 16 * nb + 4 * fq); const v2u uw = *up; v2u w;
                w.x = pk2(bflo(uw.x) * (acc[nb][0] + bias), bfhi(uw.x) * (acc[nb][1] + bias)); w.y = pk2(bflo(uw.y) * (acc[nb][2] + bias), bfhi(uw.y) * (acc[nb][3] + bias)); *up = w; }
            __syncthreads();
        }
    }
    GSYNC();

    for (int rep_ = 0; rep_ < REP_P3; ++rep_) {
        pg8::Gemm g{ZU, Wa_t, M, 1024, 1024, ZQ, Wb_t}; SegOrder S; S.S.init(M, 1024, G, bx); S.nseg = 2;
        EpiMerge E{GA, GB, TMP, MRG};
#ifndef SKIP_MRG
        pg8::gemm_phase<EpiMerge, SegOrder, true, true>(lds, g, S, E, wave0);
#endif
    }
    GSYNC();

    for (int rep_ = 0; rep_ < REP_P4; ++rep_) {
        pg8::Gemm g{MRG, Wout_t, M, 1024, 1024, MRG, Wout_t}; pg8::StaticOrder S; S.init(M, 1024, G, bx);
        EpiResid E{x, X1, XN, SS1};
        pg8::gemm_phase<EpiResid, pg8::StaticOrder, false, true>(lds, g, S, E, wave0);
    }
    GSYNC();

    for (int rep_ = 0; rep_ < REP_P5; ++rep_) {
        pg8::Gemm g{XN, Wup_t, M, NUP, 1024, XN, Wup_t}; pg8::StaticOrder S; S.init(M, NUP, G, bx);
        EpiUp E{SS1, args.in[14], args.in[15], ACT, RAWB};
#ifndef SKIP_UP
        pg8::gemm_phase<EpiUp, pg8::StaticOrder, true, true>(lds, g, S, E, wave0);
#endif
    }
    GSYNC();

    {
        FRESH_TID();
        pg8::StaticOrder S; S.init(M, 1024, G, bx); pg8::Unit u0;
        if (S.next(0, u0)) {
            const float* cw = args.in[14]; const float* cbias = args.in[15];
            for (int e = tid; e < 4 * FF; e += NTHR) {
                const int i = e / FF, ch = e % FF, rb = 4 * u0.pm + i; const bool first = (rb & 31) == 0;
                float cvv[2][2];
#pragma unroll
                for (int bj = 0; bj < 2; ++bj) {
                    const int colT = (ch >> 7) * 256 + bj * 128 + (ch & 127), cc = bj * FF + ch;
                    const float c0 = RAWB[((size_t)rb * 4 + 0) * NUP + colT], c1 = RAWB[((size_t)rb * 4 + 1) * NUP + colT];
                    const float p62 = first ? 0.f : RAWB[((size_t)(rb - 1) * 4 + 2) * NUP + colT], p63 = first ? 0.f : RAWB[((size_t)(rb - 1) * 4 + 3) * NUP + colT];
                    const float w0 = cw[cc], w1 = cw[NUP + cc], w2 = cw[2 * NUP + cc], bb = cbias[cc];
                    cvv[bj][0] = bb + w0 * p62 + w1 * p63 + w2 * c0; cvv[bj][1] = bb + w0 * p63 + w1 * c0 + w2 * c1;
                }
                ACT[(size_t)(64 * rb) * FF + ch] = (bf16)f2bf(gelu_t(cvv[0][0]) * cvv[1][0]);
                ACT[(size_t)(64 * rb + 1) * FF + ch] = (bf16)f2bf(gelu_t(cvv[0][1]) * cvv[1][1]);
            }
        }
        VM_WAIT(); __syncthreads();
        pg8::Gemm g{ACT, Wdn_t, M, 1024, FF, ACT, Wdn_t};
        EpiResid E{X1, X1, XN, SS2};
        pg8::gemm_phase<EpiResid, pg8::StaticOrder, false, true>(lds, g, S, E, wave0);
    }
    GSYNC();

    for (int rep_ = 0; rep_ < REP_P8; ++rep_) {
        pg8::StaticOrder S; S.init(M, 1024, G, bx);
        { pg8::Gemm g{PB, Wple_t, M, 1024, PLED, PB, Wple_t}; EpiPlain E{PLEB}; pg8::gemm_phase<EpiPlain, pg8::StaticOrder, false, true>(lds, g, S, E, wave0); }
        VM_WAIT(); __syncthreads();
        { pg8::Gemm g{XN, Wpg_t, M, 1024, 1024, XN, Wpg_t}; EpiPleGate E{X1, PLEB, SS2, args.out, SS3}; pg8::gemm_phase<EpiPleGate, pg8::StaticOrder, false, true>(lds, g, S, E, wave0); }
    }
    GSYNC();

    {
        FRESH_TID();
        const float* gf = args.in[20];
        for (int m = gw; m < M; m += NGW) {
            const f32x4 s4 = *(const f32x4*)(SS3 + (size_t)m * 4); const float rstd = 1.0f / sqrtf(((s4[0] + s4[1]) + (s4[2] + s4[3])) * (1.0f / 1024.0f) + EPS);
            f32x4* xr = (f32x4*)(args.out + (size_t)m * 1024) + lane;
#pragma unroll
            for (int j = 0; j < 4; ++j) { const f32x4 g4 = ((const f32x4*)gf)[lane + 64 * j]; xr[64 * j] = xr[64 * j] * rstd * g4; }
        }
    }
}

extern "C" void kernel_launch(void* const* d_in, const int* in_sizes, int n_in, void* d_out, int out_size, void* d_ws, size_t ws_size, hipStream_t stream) {
    static int grid = 0;
    if (grid == 0) {
        if (n_in != 21 || out_size != M * 1024 || ws_size < WS_END) { fprintf(stderr, "kernel_launch: unexpected shapes (n_in %d out %d ws %zu)\n", n_in, out_size, ws_size); grid = -1; return; }
        int dev = 0, cus = 0, per_cu = 0;
        hipGetDevice(&dev); hipDeviceGetAttribute(&cus, hipDeviceAttributeMultiprocessorCount, dev);
        if (hipFuncSetAttribute((const void*)fwd_mega, hipFuncAttributeMaxDynamicSharedMemorySize, LDS_BYTES) != hipSuccess) { fprintf(stderr, "kernel_launch: hipFuncSetAttribute failed\n"); grid = -1; return; }
        if (hipOccupancyMaxActiveBlocksPerMultiprocessor(&per_cu, (const void*)fwd_mega, NTHR, LDS_BYTES) != hipSuccess || per_cu < 1) { fprintf(stderr, "kernel_launch: occupancy query gave %d\n", per_cu); per_cu = 1; }
        (void)hipGetLastError();
        grid = cus;
        fprintf(stderr, "kernel_launch: grid %d (cus %d, per_cu %d)\n", grid, cus, per_cu);
    }
    if (grid < 0) return;
    Args a{};
    for (int i = 0; i < 21; ++i) a.in[i] = (const float*)d_in[i];
    a.out = (float*)d_out; a.ws = (unsigned char*)d_ws;
    void* kargs[] = {&a};
    hipError_t e = hipLaunchCooperativeKernel((const void*)fwd_mega, dim3(grid), dim3(NTHR), kargs, LDS_BYTES, stream);
    if (e != hipSuccess) fprintf(stderr, "kernel_launch: cooperative launch failed: %s (grid %d)\n", hipGetErrorString(e), grid);
}
```
